# Optimizing an MI355X kernel written in HIP

```python
import jax, jax.numpy as jnp
from jax import lax
import numpy as np

D_MODEL = 2048
BATCH = 2
SEQ = 16384
DEPTH = 2

GRID_W = 64
CTX_LEN = 256
HEAD_DIM = 128
N_Q_HEADS = 12
N_KV_HEADS = 4
GQA_GROUP = N_Q_HEADS // N_KV_HEADS
WINDOW = 128
BLOCK = WINDOW
ATTN_WIDTH = N_Q_HEADS * HEAD_DIM
KV_WIDTH = N_KV_HEADS * HEAD_DIM
FOURIER_WIDTH = D_MODEL - ATTN_WIDTH
FOURIER_GROUPS = 4
FOURIER_GROUP_DIM = FOURIER_WIDTH // FOURIER_GROUPS
MIX0_WIDTH = ATTN_WIDTH + FOURIER_WIDTH
SPLIT0 = (ATTN_WIDTH, ATTN_WIDTH + KV_WIDTH, ATTN_WIDTH + 2 * KV_WIDTH,
          ATTN_WIDTH + 2 * KV_WIDTH + FOURIER_WIDTH)
IN0_WIDTH = ATTN_WIDTH + 2 * KV_WIDTH + FOURIER_WIDTH + MIX0_WIDTH
POOL_WINDOWS = (2, 4, 8, 16)
POOL_GROUPS = len(POOL_WINDOWS)
POOL_WIDTH = D_MODEL
POOL_GROUP_DIM = POOL_WIDTH // POOL_GROUPS
IN1_WIDTH = 2 * POOL_WIDTH
ROPE_BASE = 10000.0
ROPE_PAIRS_PER_AXIS = HEAD_DIM // 4
RMS_EPS = 1e-6

kernel_name = "hybrid_swa_fourier_pool_prefix_dit"


def rmsnorm(x, g):
    xf = x.astype(jnp.float32)
    y = xf * lax.rsqrt(jnp.mean(xf * xf, axis=-1, keepdims=True) + RMS_EPS)
    return (y * g.astype(jnp.float32)).astype(x.dtype)


def adaln(cond, w_mod, b_mod):
    m = jax.nn.silu(cond) @ w_mod + b_mod
    return jnp.split(m, 3, axis=-1)


def axial_rope(rows):
    row = jnp.repeat(jnp.arange(rows, dtype=jnp.float32), GRID_W)
    col = jnp.tile(jnp.arange(GRID_W, dtype=jnp.float32), rows)
    inv = 1.0 / (ROPE_BASE ** (jnp.arange(ROPE_PAIRS_PER_AXIS, dtype=jnp.float32) / ROPE_PAIRS_PER_AXIS))
    ang = jnp.stack([row[:, None] * inv, col[:, None] * inv], axis=1)
    return jnp.cos(ang), jnp.sin(ang)


def apply_rope(x, cos, sin):
    B, S, H, _ = x.shape
    xr = x.reshape(B, S, H, 2, 2, ROPE_PAIRS_PER_AXIS).astype(jnp.float32)
    x1, x2 = xr[..., 0, :], xr[..., 1, :]
    cs, sn = cos[None, :, None], sin[None, :, None]
    out = jnp.stack([x1 * cs - x2 * sn, x2 * cs + x1 * sn], axis=-2)
    return out.reshape(B, S, H, HEAD_DIM).astype(x.dtype)


def sink_logits(sink, lead_shape):
    s = sink.astype(jnp.float32).reshape(1, N_KV_HEADS, GQA_GROUP, 1, 1)
    return jnp.broadcast_to(s, lead_shape + (1,))


def windowed_attention(q, k, v, k_ctx, v_ctx, sink):
    B, S = q.shape[:2]
    C = k_ctx.shape[1]
    nblk = S // BLOCK
    scale = HEAD_DIM ** -0.5
    pad = ((0, 0), (WINDOW, WINDOW), (0, 0), (0, 0))
    kp = jnp.pad(k, pad)
    vp = jnp.pad(v, pad)
    qb = q.reshape(B, nblk, BLOCK, N_KV_HEADS, GQA_GROUP, HEAD_DIM).transpose(1, 0, 2, 3, 4, 5)

    def attend_block(args):
        n, qn = args
        kw = lax.dynamic_slice_in_dim(kp, n * BLOCK, BLOCK + 2 * WINDOW, axis=1)
        vw = lax.dynamic_slice_in_dim(vp, n * BLOCK, BLOCK + 2 * WINDOW, axis=1)
        s_win = jnp.einsum('bqkgd,bjkd->bkgqj', qn, kw).astype(jnp.float32) * scale
        s_ctx = jnp.einsum('bqkgd,bjkd->bkgqj', qn, k_ctx).astype(jnp.float32) * scale
        kpos = n * BLOCK - WINDOW + jnp.arange(BLOCK + 2 * WINDOW)
        qpos = n * BLOCK + jnp.arange(BLOCK)
        valid = (jnp.abs(kpos[None, :] - qpos[:, None]) <= WINDOW) & (kpos >= 0)[None, :] & (kpos < S)[None, :]
        s_win = jnp.where(valid, s_win, -jnp.inf)
        logits = jnp.concatenate([sink_logits(sink, s_win.shape[:-1]), s_ctx, s_win], axis=-1)
        p = jax.nn.softmax(logits, axis=-1)
        p_ctx = p[..., 1:1 + C].astype(v.dtype)
        p_win = p[..., 1 + C:].astype(v.dtype)
        return (jnp.einsum('bkgqj,bjkd->bqkgd', p_ctx, v_ctx)
                + jnp.einsum('bkgqj,bjkd->bqkgd', p_win, vw))

    out = lax.map(attend_block, (jnp.arange(nblk), qb))
    return out.transpose(1, 0, 2, 3, 4, 5).reshape(B, S, ATTN_WIDTH)


def context_attention(q, k, v, sink):
    B, C = q.shape[:2]
    qg = q.reshape(B, C, N_KV_HEADS, GQA_GROUP, HEAD_DIM)
    s = jnp.einsum('bqkgd,bjkd->bkgqj', qg, k).astype(jnp.float32) * (HEAD_DIM ** -0.5)
    logits = jnp.concatenate([sink_logits(sink, s.shape[:-1]), s], axis=-1)
    p = jax.nn.softmax(logits, axis=-1)[..., 1:].astype(v.dtype)
    return jnp.einsum('bkgqj,bjkd->bqkgd', p, v).reshape(B, C, ATTN_WIDTH)


def fourier_mix(f, w_f):
    B, N, _ = f.shape
    fg = f.reshape(B, N, FOURIER_GROUPS, FOURIER_GROUP_DIM).astype(jnp.float32)
    z = jnp.fft.fft2(fg, axes=(1, 3), norm="ortho").real.astype(f.dtype)
    return jnp.einsum('bngc,gcd->bngd', z, w_f).reshape(B, N, FOURIER_WIDTH)


def multiscale_pool(u, w_grp, layer_scale):
    B, N, _ = u.shape
    ug = u.reshape(B, N, POOL_GROUPS, POOL_GROUP_DIM)
    cs = jnp.concatenate([jnp.zeros((B, 1, POOL_GROUPS, POOL_GROUP_DIM), jnp.float32),
                          jnp.cumsum(ug.astype(jnp.float32), axis=1)], axis=1)
    t = jnp.arange(N)[:, None]
    w = jnp.array(POOL_WINDOWS, dtype=jnp.int32)[None, :]
    lo = jnp.clip(t - w // 2, 0, N)
    hi = jnp.clip(t - w // 2 + w, 0, N)
    gidx = jnp.arange(POOL_GROUPS)[None, :]
    win_sum = cs[:, hi, gidx, :] - cs[:, lo, gidx, :]
    mean = win_sum / (hi - lo).astype(jnp.float32)[None, :, :, None]
    pooled = (mean - ug.astype(jnp.float32)).astype(u.dtype)
    y = jnp.einsum('bngc,gcd->bngd', pooled, w_grp).reshape(B, N, POOL_WIDTH)
    return y * layer_scale


def attn_fourier_layer(x, ctx, c, c_ctx, cos, sin, norm_g, w_mod, b_mod, w_in, sink, w_f, w_out, need_ctx_out):
    B, S, _ = x.shape
    C = ctx.shape[1]
    shift, scale, gate = adaln(c, w_mod, b_mod)
    shift_c, scale_c, gate_c = adaln(c_ctx, w_mod, b_mod)
    h = rmsnorm(x, norm_g) * (1.0 + scale[:, None]) + shift[:, None]
    hc = rmsnorm(ctx, norm_g) * (1.0 + scale_c) + shift_c

    q, k, v, f, z = jnp.split(h @ w_in, SPLIT0, axis=-1)
    q = apply_rope(q.reshape(B, S, N_Q_HEADS, HEAD_DIM), cos, sin)
    k = apply_rope(k.reshape(B, S, N_KV_HEADS, HEAD_DIM), cos, sin)
    v = v.reshape(B, S, N_KV_HEADS, HEAD_DIM)

    if need_ctx_out:
        qc, kc, vc, fc, zc = jnp.split(hc @ w_in, SPLIT0, axis=-1)
    else:
        kc, vc = jnp.split(hc @ w_in[:, ATTN_WIDTH:ATTN_WIDTH + 2 * KV_WIDTH], 2, axis=-1)
    kc = kc.reshape(B, C, N_KV_HEADS, HEAD_DIM)
    vc = vc.reshape(B, C, N_KV_HEADS, HEAD_DIM)

    y = jnp.concatenate([windowed_attention(q, k, v, kc, vc, sink), fourier_mix(f, w_f)], axis=-1)
    x = x + gate[:, None] * ((y * jax.nn.silu(z)) @ w_out)

    if need_ctx_out:
        qc = qc.reshape(B, C, N_Q_HEADS, HEAD_DIM)
        yc = jnp.concatenate([context_attention(qc, kc, vc, sink), fourier_mix(fc, w_f)], axis=-1)
        ctx = ctx + gate_c * ((yc * jax.nn.silu(zc)) @ w_out)
    return x, ctx


def pool_branch(h, w_in, w_grp, layer_scale, w_out):
    u, z = jnp.split(h @ w_in, 2, axis=-1)
    return (multiscale_pool(u, w_grp, layer_scale) * jax.nn.silu(z)) @ w_out


def pool_layer(x, ctx, c, c_ctx, norm_g, w_mod, b_mod, w_in, w_grp, layer_scale, w_out, need_ctx_out):
    shift, scale, gate = adaln(c, w_mod, b_mod)
    h = rmsnorm(x, norm_g) * (1.0 + scale[:, None]) + shift[:, None]
    x = x + gate[:, None] * pool_branch(h, w_in, w_grp, layer_scale, w_out)
    if need_ctx_out:
        shift_c, scale_c, gate_c = adaln(c_ctx, w_mod, b_mod)
        hc = rmsnorm(ctx, norm_g) * (1.0 + scale_c) + shift_c
        ctx = ctx + gate_c * pool_branch(hc, w_in, w_grp, layer_scale, w_out)
    return x, ctx


def setup_inputs(seed: int = 0) -> dict:
    key = jax.random.key(seed)
    ks = jax.random.split(key, 20)
    D = D_MODEL
    nrm = jax.random.normal
    f32 = jnp.float32
    return {
        "x": nrm(ks[0], (BATCH, SEQ, D), f32),
        "c": nrm(ks[1], (BATCH, D), f32),
        "ctx": nrm(ks[2], (BATCH, CTX_LEN, D), f32),
        "c_ctx": nrm(ks[3], (D,), f32),
        "l0_norm": 1.0 + 0.1 * nrm(ks[4], (D,), f32),
        "l0_w_mod": nrm(ks[5], (D, 3 * D), f32) * (0.5 * D ** -0.5),
        "l0_b_mod": 0.02 * nrm(ks[6], (3 * D,), f32),
        "l0_w_in": nrm(ks[7], (D, IN0_WIDTH), f32) * D ** -0.5,
        "l0_sink": nrm(ks[8], (N_Q_HEADS,), f32),
        "l0_w_f": nrm(ks[9], (FOURIER_GROUPS, FOURIER_GROUP_DIM, FOURIER_GROUP_DIM), f32) * FOURIER_GROUP_DIM ** -0.5,
        "l0_w_out": nrm(ks[10], (MIX0_WIDTH, D), f32) * MIX0_WIDTH ** -0.5,
        "l1_norm": 1.0 + 0.1 * nrm(ks[11], (D,), f32),
        "l1_w_mod": nrm(ks[12], (D, 3 * D), f32) * (0.5 * D ** -0.5),
        "l1_b_mod": 0.02 * nrm(ks[13], (3 * D,), f32),
        "l1_w_in": nrm(ks[14], (D, IN1_WIDTH), f32) * D ** -0.5,
        "l1_w_grp": nrm(ks[15], (POOL_GROUPS, POOL_GROUP_DIM, POOL_GROUP_DIM), f32) * POOL_GROUP_DIM ** -0.5,
        "l1_scale": 1.0 + 0.1 * nrm(ks[16], (POOL_WIDTH,), f32),
        "l1_w_out": nrm(ks[17], (POOL_WIDTH, D), f32) * POOL_WIDTH ** -0.5,
        "final_norm": 1.0 + 0.1 * nrm(ks[18], (D,), f32),
    }


def reference(x, c, ctx, c_ctx,
              l0_norm, l0_w_mod, l0_b_mod, l0_w_in, l0_sink, l0_w_f, l0_w_out,
              l1_norm, l1_w_mod, l1_b_mod, l1_w_in, l1_w_grp, l1_scale, l1_w_out,
              final_norm):
    ROWS = x.shape[1] // GRID_W
    cos, sin = axial_rope(ROWS)
    layer_params = [
        (l0_norm, l0_w_mod, l0_b_mod, l0_w_in, l0_sink, l0_w_f, l0_w_out),
        (l1_norm, l1_w_mod, l1_b_mod, l1_w_in, l1_w_grp, l1_scale, l1_w_out),
    ]
    for i in range(DEPTH):
        need_ctx_out = any(j % 2 == 0 for j in range(i + 1, DEPTH))
        if i % 2 == 0:
            x, ctx = attn_fourier_layer(x, ctx, c, c_ctx, cos, sin, *layer_params[i], need_ctx_out)
        else:
            x, ctx = pool_layer(x, ctx, c, c_ctx, *layer_params[i], need_ctx_out)
    return rmsnorm(x, final_norm)
```

```cpp
#include <hip/hip_runtime.h>
#include <hip/hip_cooperative_groups.h>
#include <cstdio>
namespace cg = cooperative_groups;
namespace pg8 {
#define PG8_LAS __attribute__((address_space(3)))
typedef unsigned short bf16_t;
typedef short bf16x8 __attribute__((ext_vector_type(8)));
typedef float f32x4 __attribute__((ext_vector_type(4)));
typedef unsigned u32x4 __attribute__((ext_vector_type(4)));
constexpr int BM = 256, BK = 64, HALF = 128, HTB = HALF * BK * 2  , STAGE_BYTES = 8 * HTB, NXCD = 8, WGM = 8;

__host__ __device__ __forceinline__ int lds_byte(int r, int c) { const int st = (r >> 4) * 2 + (c >> 5), rr = r & 15, cc = c & 31, ob = rr * 64 + cc * 2; return st * 1024 + (ob ^ (((ob >> 9) & 1) << 5)); }
__host__ __device__ __forceinline__ void stage_rc(int b, int& R, int& C) { const int st = b / 1024, sb = b % 1024, swz = sb ^ (((sb >> 9) & 1) << 5); R = (st >> 1) * 16 + swz / 64; C = (st & 1) * 32 + (swz % 64) / 2; }
__host__ __device__ __forceinline__ int perm32(int rho) { const int n = rho >> 4, i = rho & 15; return 8 * (i >> 2) + 4 * n + (i & 3); }

struct Unit { int pm, pn; };
struct Gemm { const bf16_t* A; const bf16_t* Bt; int M, N, K, lda, ldb; };

struct StaticOrder {
    int nM, nN, nwg, G, c;
    __host__ __device__ void init(int M, int N, int G_, int c_) { nM = M / BM; nN = N / BM; nwg = nM * nN; G = G_; c = c_; }
    __host__ __device__ bool next(int i, Unit& u) const {
        const long L = (long)i * G + c; if (L >= nwg) return false;
        int wgid = (int)L; { const int q = nwg / NXCD, r = nwg % NXCD, xcd = wgid % NXCD, off = wgid / NXCD; wgid = (xcd < r ? xcd * (q + 1) : r * (q + 1) + (xcd - r) * q) + off; }
        const int nig = WGM * nN, gid = wgid / nig, fm = gid * WGM, gsz = (nM - fm) < WGM ? (nM - fm) : WGM;
        u.pm = fm + ((wgid % nig) % gsz); u.pn = (wgid % nig) / gsz; return true;
    }
    __device__ __forceinline__ void a_ready(const Unit&) const {}
    __device__ __forceinline__ void done(const Unit&) const {}
};
__device__ __forceinline__ unsigned cvt_pk_bf16(float lo, float hi) { unsigned r; asm("v_cvt_pk_bf16_f32 %0, %1, %2" : "=v"(r) : "v"(lo), "v"(hi)); return r; }
template <class Epi, class Sched, bool STAMP = false>
__device__ __forceinline__ void gemm_phase(PG8_LAS unsigned char* lds, const Gemm g, const Sched& S, const Epi& E, unsigned long long* stamps) {
    const int tid = threadIdx.x, wid = __builtin_amdgcn_readfirstlane(tid >> 6), lane = tid & 63, wr = wid >> 2, wc = wid & 3, fr = lane & 15, fq = lane >> 4;
    const int K = g.K, nt = K / BK;
    int ts_lo = 0, ts_hi = 0, nts = 0; const unsigned long long rt_entry = STAMP ? (unsigned long long)wall_clock64() : 0ull;
#define PG8_STAMP() do { if (STAMP && wid == 0 && nts < 64) { const unsigned long long _c = (unsigned long long)clock64(); \
        ts_lo = (lane == nts) ? (int)(unsigned)_c : ts_lo; ts_hi = (lane == nts) ? (int)(unsigned)(_c >> 32) : ts_hi; ++nts; } } while (0)
    PG8_STAMP();
    unsigned voffA[2], voffB[2];
#pragma unroll
    for (int i = 0; i < 2; ++i) { int R, C; stage_rc(tid * 16 + i * 8192, R, C); const int Rb = Epi::PERM ? ((R & ~31) + perm32(R & 31)) : R;
        voffA[i] = (unsigned)(R * g.lda + C) * 2u; voffB[i] = (unsigned)(Rb * g.ldb + C) * 2u; }
    const size_t kstep = (size_t)(BK * 2);
    const size_t hstepA = (size_t)HALF * g.lda * 2, hstepB = (size_t)HALF * g.ldb * 2;
    const size_t tstepA = 2 * hstepA, tstepB = 2 * hstepB;
    const unsigned ldsw = (unsigned)wid * 1024u;
    const int aoff = lds_byte(wr * 64 + fr, fq * 8), boff = lds_byte(wc * 32 + fr, fq * 8);
#define PG8_SA(b, h) (((b) * 2 + (h)) * HTB)
#define PG8_SB(b, h) ((4 + (b) * 2 + (h)) * HTB)
#define PG8_STAGE(bufoff, gbase, voff) do { _Pragma("unroll") for (int _i = 0; _i < 2; ++_i) \
        __builtin_amdgcn_global_load_lds((const unsigned*)((const char*)(gbase) + (voff)[_i]), (PG8_LAS unsigned*)(lds + (bufoff) + ldsw + _i * 8192), 16, 0, 0); } while (0)
#define PG8_LDA(dst, b, h) do { _Pragma("unroll") for (int m = 0; m < 4; ++m) _Pragma("unroll") for (int k = 0; k < 2; ++k) dst[m][k] = *(const PG8_LAS bf16x8*)(lds + PG8_SA(b, h) + aoff + m * 2048 + k * 1024); } while (0)
#define PG8_LDB(dst, b, h) do { _Pragma("unroll") for (int n = 0; n < 2; ++n) _Pragma("unroll") for (int k = 0; k < 2; ++k) dst[n][k] = *(const PG8_LAS bf16x8*)(lds + PG8_SB(b, h) + boff + n * 2048 + k * 1024); } while (0)
#define PG8_MMA(ai, bj, At, Bt) do { __builtin_amdgcn_s_setprio(1); _Pragma("unroll") for (int m = 0; m < 4; ++m) _Pragma("unroll") for (int n = 0; n < 2; ++n) _Pragma("unroll") for (int k = 0; k < 2; ++k) \
        acc[ai][bj][m][n] = __builtin_amdgcn_mfma_f32_16x16x32_bf16(Bt[n][k], At[m][k], acc[ai][bj][m][n], 0, 0, 0); __builtin_amdgcn_s_setprio(0); } while (0)
#define PG8_WAIT_V(n) asm volatile("s_waitcnt vmcnt(" #n ")" ::: "memory")
#define PG8_WAIT_L(n) asm volatile("s_waitcnt lgkmcnt(" #n ")" ::: "memory")
#define PG8_BAR __builtin_amdgcn_s_barrier()
#define PG8_SCHED __builtin_amdgcn_sched_barrier(0)
    Unit cur, nxt; int ui = 0;
    if (!S.next(0, cur)) return;
    f32x4 acc[2][2][4][2];
#pragma unroll
    for (int a = 0; a < 2; ++a)
#pragma unroll
        for (int b = 0; b < 2; ++b)
#pragma unroll
            for (int m = 0; m < 4; ++m)
#pragma unroll
                for (int n = 0; n < 2; ++n) acc[a][b][m][n] = (f32x4){0.f, 0.f, 0.f, 0.f};
    bf16x8 At[4][2], B0[2][2], B1[2][2];
    const char* cA = (const char*)g.A + (size_t)cur.pm * tstepA; const char* cB = (const char*)g.Bt + (size_t)cur.pn * tstepB;
    S.a_ready(cur);
    PG8_STAGE(PG8_SB(0, 0), cB, voffB); PG8_STAGE(PG8_SA(0, 0), cA, voffA); PG8_STAGE(PG8_SB(0, 1), cB + hstepB, voffB); PG8_STAGE(PG8_SA(0, 1), cA + hstepA, voffA);
    if (wr == 1) PG8_BAR;
    PG8_WAIT_V(4); PG8_BAR;
    PG8_STAGE(PG8_SB(1, 0), cB + kstep, voffB); PG8_STAGE(PG8_SA(1, 0), cA + kstep, voffA); PG8_STAGE(PG8_SB(1, 1), cB + hstepB + kstep, voffB);
    PG8_WAIT_V(6); PG8_BAR;
    PG8_STAMP();
    for (;;) {
        const bool has_next = S.next(ui + 1, nxt);
        const char* nA = has_next ? (const char*)g.A + (size_t)nxt.pm * tstepA : cA; const char* nB = has_next ? (const char*)g.Bt + (size_t)nxt.pn * tstepB : cB;
        for (int t = 0; t < nt; t += 2) {
            const bool last = (t == nt - 2);
            const char* a1 = cA + (size_t)(t + 1) * kstep;
            const char* a2 = last ? nA : cA + (size_t)(t + 2) * kstep; const char* b2 = last ? nB : cB + (size_t)(t + 2) * kstep;
            const char* a3 = a2 + kstep; const char* b3 = b2 + kstep;
            if (last && has_next) S.a_ready(nxt);
            PG8_LDB(B0, 0, 0); PG8_SCHED; PG8_LDA(At, 0, 0); PG8_STAGE(PG8_SA(1, 1), a1 + hstepA, voffA);
            PG8_WAIT_L(8); PG8_BAR; PG8_WAIT_L(0); PG8_MMA(0, 0, At, B0); PG8_BAR; PG8_SCHED;
            PG8_LDB(B1, 0, 1); PG8_STAGE(PG8_SB(0, 0), b2, voffB);
            PG8_BAR; PG8_WAIT_L(0); PG8_MMA(0, 1, At, B1); PG8_BAR;
            PG8_LDA(At, 0, 1); PG8_STAGE(PG8_SA(0, 0), a2, voffA);
            PG8_BAR; PG8_WAIT_L(0); PG8_MMA(1, 0, At, B0); PG8_BAR; PG8_SCHED;
            PG8_STAGE(PG8_SB(0, 1), b2 + hstepB, voffB);
            PG8_WAIT_V(6); PG8_BAR; PG8_MMA(1, 1, At, B1); PG8_BAR;
            PG8_LDB(B0, 1, 0); PG8_SCHED; PG8_LDA(At, 1, 0); PG8_STAGE(PG8_SA(0, 1), a2 + hstepA, voffA);
            PG8_WAIT_L(8); PG8_BAR; PG8_WAIT_L(0); PG8_MMA(0, 0, At, B0); PG8_BAR; PG8_SCHED;
            PG8_LDB(B1, 1, 1); PG8_STAGE(PG8_SB(1, 0), b3, voffB);
            PG8_BAR; PG8_WAIT_L(0); PG8_MMA(0, 1, At, B1); PG8_BAR;
            PG8_LDA(At, 1, 1); PG8_STAGE(PG8_SA(1, 0), a3, voffA);
            PG8_BAR; PG8_WAIT_L(0); PG8_MMA(1, 0, At, B0); PG8_BAR; PG8_SCHED;
            PG8_STAGE(PG8_SB(1, 1), b3 + hstepB, voffB);
            PG8_WAIT_V(6); PG8_BAR; PG8_MMA(1, 1, At, B1); PG8_BAR;
        }
        PG8_STAMP();
        if constexpr (!Epi::AFTER_DRAIN) { E(acc, cur, wr, wc, fr, fq); S.done(cur); }
        PG8_STAMP();
        if (!has_next) break;
#pragma unroll
        for (int a = 0; a < 2; ++a)
#pragma unroll
            for (int b = 0; b < 2; ++b)
#pragma unroll
                for (int m = 0; m < 4; ++m)
#pragma unroll
                    for (int n = 0; n < 2; ++n) acc[a][b][m][n] = (f32x4){0.f, 0.f, 0.f, 0.f};
        cur = nxt; cA = nA; cB = nB; ++ui;
    }
    PG8_WAIT_V(0);
    if (wr == 0) PG8_BAR;
    PG8_BAR;
    if constexpr (Epi::AFTER_DRAIN) { E.fused(acc, cur, wr, wc, fr, fq, lds, wid, lane); S.done(cur); }
    PG8_STAMP();
    if (STAMP && wid == 0) { stamps[lane] = lane < nts ? (((unsigned long long)(unsigned)ts_hi << 32) | (unsigned)ts_lo) : 0ull;
        if (lane == 62) stamps[62] = rt_entry; if (lane == 63) stamps[63] = (unsigned long long)wall_clock64(); }
#undef PG8_STAMP
#undef PG8_SA
#undef PG8_SB
#undef PG8_STAGE
#undef PG8_LDA
#undef PG8_LDB
#undef PG8_MMA
#undef PG8_WAIT_V
#undef PG8_WAIT_L
#undef PG8_BAR
#undef PG8_SCHED
}
}

#define LAS __attribute__((address_space(3)))
using pg8::bf16_t; using pg8::bf16x8; using pg8::f32x4; using pg8::u32x4; using pg8::cvt_pk_bf16;
typedef short s16x4 __attribute__((ext_vector_type(4)));
typedef unsigned u32x2 __attribute__((ext_vector_type(2)));
typedef float f32x2 __attribute__((ext_vector_type(2)));

constexpr int DM = 2048, SEQ = 16384, MTOK = 32768;
constexpr int LDQ = 5120;
constexpr int OFF_K = 1536, OFF_V = 2048, OFF_F = 2560, OFF_Z = 3072;
constexpr float LOG2E = 1.4426950408889634f;
constexpr float QSCALE = 0.08838834764831845f * 1.4426950408889634f;
constexpr int LDS_BYTES = 131072;

constexpr size_t WS_MOD = 0;
constexpr size_t WS_ROPE = WS_MOD + 147456;
constexpr size_t WS_DC = WS_ROPE + 81920;
constexpr size_t WS_EC = WS_DC + 65536;
constexpr size_t WS_MGT = WS_EC + 131072;
constexpr size_t WS_WTIN0 = WS_MGT + 262144;
constexpr size_t WS_WTOUT0 = WS_WTIN0 + 20971520;
constexpr size_t WS_WTIN1 = WS_WTOUT0 + 8388608;
constexpr size_t WS_WTOUT1 = WS_WTIN1 + 16777216;
constexpr size_t WS_WBF1 = WS_WTOUT1 + 8388608;
constexpr size_t WS_WGRPT = WS_WBF1 + 8388608;
constexpr size_t WS_H = WS_WGRPT + 2097152;
constexpr size_t WS_HC = WS_H + 134217728;
constexpr size_t WS_QKV = WS_HC + 2097152;
constexpr size_t WS_KCVC = WS_QKV + 335544320;
constexpr size_t WS_Y = WS_KCVC + 1048576;
constexpr size_t WS_A = WS_Y + 67108864;
constexpr size_t WS_END = WS_A + 134217728;

struct Params {
    const float *x, *c, *ctx, *c_ctx;
    const float *l0_norm, *l0_w_mod, *l0_b_mod, *l0_w_in, *l0_sink, *l0_w_f, *l0_w_out;
    const float *l1_norm, *l1_w_mod, *l1_b_mod, *l1_w_in, *l1_w_grp, *l1_scale, *l1_w_out, *final_norm;
    float* out; unsigned char* ws;
};

__device__ __forceinline__ float bflo(unsigned u) { return __uint_as_float(u << 16); }
__device__ __forceinline__ float bfhi(unsigned u) { return __uint_as_float(u & 0xffff0000u); }
__device__ __forceinline__ unsigned short f2bf(float f) { return (unsigned short)(cvt_pk_bf16(f, f) & 0xffffu); }
__device__ __forceinline__ float silu(float v) { return v * __builtin_amdgcn_rcpf(1.0f + __expf(-v)); }
__device__ __forceinline__ f32x4 mfma16(bf16x8 a, bf16x8 b, f32x4 c) { return __builtin_amdgcn_mfma_f32_16x16x32_bf16(a, b, c, 0, 0, 0); }
__device__ __forceinline__ bf16x8 tr2(LAS unsigned char* p0, LAS unsigned char* p1) {
    const s16x4 a = __builtin_amdgcn_ds_read_tr16_b64_v4i16((LAS s16x4*)p0);
    const s16x4 b = __builtin_amdgcn_ds_read_tr16_b64_v4i16((LAS s16x4*)p1);
    return __builtin_shufflevector(a, b, 0, 1, 2, 3, 4, 5, 6, 7);
}
__device__ __forceinline__ bf16x8 pack8(f32x4 a, f32x4 b) {
    u32x4 w; w.x = cvt_pk_bf16(a[0], a[1]); w.y = cvt_pk_bf16(a[2], a[3]); w.z = cvt_pk_bf16(b[0], b[1]); w.w = cvt_pk_bf16(b[2], b[3]);
    return __builtin_bit_cast(bf16x8, w);
}
__device__ __forceinline__ u32x2 pack4(f32x4 a) { u32x2 w; w.x = cvt_pk_bf16(a[0], a[1]); w.y = cvt_pk_bf16(a[2], a[3]); return w; }
__device__ __forceinline__ f32x4 unpack4(u32x2 w) { return (f32x4){bflo(w.x), bfhi(w.x), bflo(w.y), bfhi(w.y)}; }
__device__ __forceinline__ f32x4 silu4(f32x4 z) { return (f32x4){silu(z[0]), silu(z[1]), silu(z[2]), silu(z[3])}; }

template <int MODE> struct EpiB {
    static constexpr bool PERM = true, AFTER_DRAIN = false;
    bf16_t* O; int ldc; const f32x2* rope;
    __device__ __forceinline__ void operator()(const f32x4 (&acc)[2][2][4][2], const pg8::Unit& u, int wr, int wc, int fr, int fq) const {
        const int row0 = u.pm * 256 + wr * 64 + fr, col0 = u.pn * 256 + wc * 32 + 8 * fq;
#pragma unroll
        for (int ai = 0; ai < 2; ++ai)
#pragma unroll
            for (int m = 0; m < 4; ++m) {
                const int row = row0 + ai * 128 + m * 16;
                bf16_t* rowp = O + (size_t)row * ldc + col0;
#pragma unroll
                for (int bj = 0; bj < 2; ++bj) {
                    f32x4 v0 = acc[ai][bj][m][0], v1 = acc[ai][bj][m][1];
                    if (MODE == 1 && u.pn < 8) {
                        const int s = row & (SEQ - 1);
                        const int t0 = ((col0 + bj * 128) & 127) >> 1;
                        const f32x2* tp = rope + (t0 < 32 ? ((s >> 6) * 32 + t0) : ((256 + (s & 63)) * 32 + (t0 - 32)));
                        const f32x4 c01 = *(const f32x4*)tp, c23 = *(const f32x4*)(tp + 2);
                        const float sc = (u.pn < 6) ? QSCALE : 1.0f;
                        f32x4 r0, r1;
                        r0[0] = (v0[0] * c01[0] - v0[1] * c01[1]) * sc; r0[1] = (v0[1] * c01[0] + v0[0] * c01[1]) * sc;
                        r0[2] = (v0[2] * c01[2] - v0[3] * c01[3]) * sc; r0[3] = (v0[3] * c01[2] + v0[2] * c01[3]) * sc;
                        r1[0] = (v1[0] * c23[0] - v1[1] * c23[1]) * sc; r1[1] = (v1[1] * c23[0] + v1[0] * c23[1]) * sc;
                        r1[2] = (v1[2] * c23[2] - v1[3] * c23[3]) * sc; r1[3] = (v1[3] * c23[2] + v1[2] * c23[3]) * sc;
                        v0 = r0; v1 = r1;
                    }
                    u32x4 w; w.x = cvt_pk_bf16(v0[0], v0[1]); w.y = cvt_pk_bf16(v0[2], v0[3]); w.z = cvt_pk_bf16(v1[0], v1[1]); w.w = cvt_pk_bf16(v1[2], v1[3]);
                    *(u32x4*)(rowp + bj * 128) = w;
                }
            }
    }
};
struct EpiRes {
    static constexpr bool PERM = false, AFTER_DRAIN = false;
    const float* base; float* out; const float* gate;
    __device__ __forceinline__ void operator()(const f32x4 (&acc)[2][2][4][2], const pg8::Unit& u, int wr, int wc, int fr, int fq) const {
        const int row0 = u.pm * 256 + wr * 64 + fr, col0 = u.pn * 256 + wc * 32 + 4 * fq;
        const float* gp = gate + (size_t)(u.pm >> 6) * 6144 + col0;
        f32x4 gv[2][2];
#pragma unroll
        for (int bj = 0; bj < 2; ++bj)
#pragma unroll
            for (int n = 0; n < 2; ++n) gv[bj][n] = *(const f32x4*)(gp + bj * 128 + n * 16);
#pragma unroll
        for (int ai = 0; ai < 2; ++ai)
#pragma unroll
            for (int m = 0; m < 4; ++m) {
                const size_t off = (size_t)(row0 + ai * 128 + m * 16) * DM + col0;
#pragma unroll
                for (int bj = 0; bj < 2; ++bj)
#pragma unroll
                    for (int n = 0; n < 2; ++n) {
                        const f32x4 bs = *(const f32x4*)(base + off + bj * 128 + n * 16);
                        *(f32x4*)(out + off + bj * 128 + n * 16) = bs + gv[bj][n] * acc[ai][bj][m][n];
                    }
                asm volatile("" ::: "memory");
            }
    }
};
struct OneUnit {
    int has; pg8::Unit u;
    __device__ bool next(int i, pg8::Unit& o) const { if (i > 0 || !has) return false; o = u; return true; }
    __device__ __forceinline__ void a_ready(const pg8::Unit&) const {}
    __device__ __forceinline__ void done(const pg8::Unit&) const {}
};

__device__ __forceinline__ void transpose_tile(const float* W, int ldw, int k0, int n0, bf16_t* Wt, int ldt, int nd0, bool ropeperm, LAS bf16_t* tt) {
    const int tid = threadIdx.x;
#pragma unroll
    for (int it = 0; it < 8; ++it) {
        const int idx = it * 512 + tid, kk = idx >> 5, n4 = (idx & 31) * 4;
        const f32x4 v = *(const f32x4*)(W + (size_t)(k0 + kk) * ldw + n0 + n4);
#pragma unroll
        for (int e = 0; e < 4; ++e) {
            int nn = n4 + e;
            if (ropeperm) { const int hs = (nn >> 5) & 1, t = (nn & 31) + ((nn >> 6) << 5); nn = 2 * t + hs; }
            tt[nn * 132 + kk] = f2bf(v[e]);
        }
    }
    __syncthreads();
#pragma unroll
    for (int it = 0; it < 8; ++it) {
        const int idx = it * 512 + tid, nn = idx >> 5, ch = idx & 31;
        const u32x2 w = *(const LAS u32x2*)(tt + nn * 132 + ch * 4);
        *(u32x2*)(Wt + (size_t)(nd0 + nn) * ldt + k0 + ch * 4) = w;
    }
    __syncthreads();
}

__device__ void phase0(const Params& p, LAS unsigned char* lds) {
    const int tid = threadIdx.x;
    LAS float* sc = (LAS float*)lds;
    LAS float* red = (LAS float*)(lds + 24576);
    LAS float* trig = (LAS float*)(lds + 49152);
    LAS bf16_t* tt = (LAS bf16_t*)(lds + 53248);
    unsigned char* ws = p.ws;
    for (int i = tid; i < 3 * DM; i += 512) { const int r = i >> 11, k = i & 2047; const float v = r < 2 ? p.c[r * DM + k] : p.c_ctx[k]; sc[i] = silu(v); }
    if (tid < 128) { float s, c; sincospif((float)tid * (1.0f / 64.0f), &s, &c); trig[tid] = c; trig[128 + tid] = s; }
    __syncthreads();
    constexpr int J0 = 192, J1 = J0 + 640, J2 = J1 + 256, J3 = J2 + 256, J4 = J3 + 256, J5 = J4 + 64, J6 = J5 + 256, J7 = J6 + 20, J8 = J7 + 64, J9 = J8 + 128, J10 = J9 + 256;
    for (int job = blockIdx.x; job < J10; job += gridDim.x) {
        if (job < J0) {
            const int L = job / 96, cc = job % 96;
            const float* wm = L ? p.l1_w_mod : p.l0_w_mod; const float* bm = L ? p.l1_b_mod : p.l0_b_mod;
            const int sub = tid & 15, rg = tid >> 4, col = cc * 64 + sub * 4;
            f32x4 a0 = {0.f, 0.f, 0.f, 0.f}, a1 = a0, a2 = a0;
            const float* wp = wm + (size_t)(rg * 64) * 6144 + col;
#pragma unroll 8
            for (int i = 0; i < 64; ++i) {
                const f32x4 w = *(const f32x4*)(wp + (size_t)i * 6144);
                const int k = rg * 64 + i;
                a0 += sc[k] * w; a1 += sc[2048 + k] * w; a2 += sc[4096 + k] * w;
            }
#pragma unroll
            for (int e = 0; e < 4; ++e) { red[(rg * 3 + 0) * 64 + sub * 4 + e] = a0[e]; red[(rg * 3 + 1) * 64 + sub * 4 + e] = a1[e]; red[(rg * 3 + 2) * 64 + sub * 4 + e] = a2[e]; }
            __syncthreads();
            if (tid < 192) {
                const int r = tid >> 6, cl = tid & 63; float s = bm[cc * 64 + cl];
                for (int g = 0; g < 32; ++g) s += red[(g * 3 + r) * 64 + cl];
                ((float*)(ws + WS_MOD))[(size_t)(L * 3 + r) * 6144 + cc * 64 + cl] = s;
            }
            __syncthreads();
        } else if (job < J1) {
            const int j = job - J0, nt = j % 40, kt = j / 40;
            transpose_tile(p.l0_w_in, 5120, kt * 128, nt * 128, (bf16_t*)(ws + WS_WTIN0), 2048, nt * 128, nt < 16, tt);
        } else if (job < J2) {
            const int j = job - J1, nt = j & 15, kt = j >> 4;
            transpose_tile(p.l0_w_out, 2048, kt * 128, nt * 128, (bf16_t*)(ws + WS_WTOUT0), 2048, nt * 128, false, tt);
        } else if (job < J3) {
            const int j = job - J2, nt = j & 15, kt = j >> 4;
            transpose_tile(p.l1_w_in, 4096, kt * 128, 2048 + nt * 128, (bf16_t*)(ws + WS_WTIN1), 2048, 2048 + nt * 128, false, tt);
        } else if (job < J4) {
            const int j = job - J3, nt = j & 15, kt = j >> 4;
            transpose_tile(p.l1_w_out, 2048, kt * 128, nt * 128, (bf16_t*)(ws + WS_WTOUT1), 2048, nt * 128, false, tt);
        } else if (job < J5) {
            const int j = job - J4, g = j >> 4, nt = j & 3, kt = (j >> 2) & 3;
            transpose_tile(p.l1_w_grp + (size_t)g * 262144, 512, kt * 128, nt * 128, (bf16_t*)(ws + WS_WGRPT) + (size_t)g * 262144, 512, nt * 128, false, tt);
        } else if (job < J6) {
            const int j = job - J5;
#pragma unroll
            for (int q = 0; q < 4; ++q) {
                const int e = (q * 512 + tid) * 8, row = j * 8 + (e >> 11), col = e & 2047;
                const float* sp = p.l1_w_in + (size_t)row * 4096 + col;
                const f32x4 v0 = *(const f32x4*)sp, v1 = *(const f32x4*)(sp + 4);
                *(bf16x8*)((bf16_t*)(ws + WS_WBF1) + (size_t)row * 2048 + col) = pack8(v0, v1);
            }
        } else if (job < J7) {
            const int e = (job - J6) * 512 + tid, pos = e >> 5, t = e & 31;
            const float pv = (float)(pos < 256 ? pos : pos - 256);
            const float inv = exp2f(-(float)t * (13.287712379549449f / 32.0f));
            float xr = pv * inv * 0.3183098861837907f;
            xr = xr - 2.0f * rintf(xr * 0.5f);
            float s, c; sincospif(xr, &s, &c);
            ((f32x2*)(ws + WS_ROPE))[e] = (f32x2){c, s};
        } else if (job < J8) {
            const int e = (job - J7) * 512 + tid, row = e >> 7, n1 = e & 127, kind = row >> 7, k1 = row & 127, ix = (k1 * n1) & 127;
            ((bf16_t*)(ws + WS_DC))[e] = f2bf(kind ? -trig[128 + ix] : trig[ix]);
        } else if (job < J9) {
            const int e = (job - J8) * 512 + tid, row = e >> 8, col = e & 255, kp = row >> 7, k2 = row & 127, kd = col >> 7, n2 = col & 127, ix = (k2 * n2) & 127;
            const float c = trig[ix], s = trig[128 + ix];
            ((bf16_t*)(ws + WS_EC))[e] = f2bf(kp == 0 ? (kd == 0 ? c : s) : (kd == 0 ? -s : c));
        } else {
            const int e = (job - J9) * 512 + tid, dp = e & 127, kc = (e >> 7) & 255, g = e >> 15, kind = kc >> 7, c = kc & 127;
            const float* wf = p.l0_w_f + (size_t)g * 16384 + dp; float s = 0.f;
            for (int m = 0; m < 128; ++m) s += trig[kind * 128 + ((m * c) & 127)] * wf[m * 128];
            ((bf16_t*)(ws + WS_MGT))[(size_t)(g * 128 + dp) * 256 + kc] = f2bf(s * 6.905339660024878e-4f);
        }
    }
}

__device__ void norm_mod_phase(const float* src, bf16_t* dst, const float* gamma, const float* modL, const float* ctx, bf16_t* hc) {
    const int lane = threadIdx.x & 63, gw = blockIdx.x * 8 + (threadIdx.x >> 6), nw = gridDim.x * 8;
    const int total = ctx ? MTOK + 512 : MTOK;
    for (int r = gw; r < total; r += nw) {
        const float* s; bf16_t* d; const float* mr;
        if (r < MTOK) { s = src + (size_t)r * DM; d = dst + (size_t)r * DM; mr = modL + (r >> 14) * 6144; }
        else { s = ctx + (size_t)(r - MTOK) * DM; d = hc + (size_t)(r - MTOK) * DM; mr = modL + 2 * 6144; }
        f32x4 v[8]; float ss = 0.f;
#pragma unroll
        for (int j = 0; j < 8; ++j) { v[j] = ((const f32x4*)s)[lane + 64 * j]; ss += v[j][0] * v[j][0] + v[j][1] * v[j][1] + v[j][2] * v[j][2] + v[j][3] * v[j][3]; }
#pragma unroll
        for (int o = 32; o >= 1; o >>= 1) ss += __shfl_xor(ss, o);
        const float rs = rsqrtf(ss * (1.0f / 2048.0f) + 1e-6f);
#pragma unroll
        for (int j = 0; j < 8; ++j) {
            const int c4 = lane + 64 * j;
            const f32x4 g = ((const f32x4*)gamma)[c4], sh = ((const f32x4*)mr)[c4], scl = ((const f32x4*)mr)[512 + c4];
            const f32x4 y = (v[j] * rs) * g * (1.0f + scl) + sh;
            *(u32x2*)(d + 4 * c4) = pack4(y);
        }
    }
}
__device__ void final_norm_phase(float* io, const float* gamma) {
    const int lane = threadIdx.x & 63, gw = blockIdx.x * 8 + (threadIdx.x >> 6), nw = gridDim.x * 8;
    for (int r = gw; r < MTOK; r += nw) {
        f32x4* s = (f32x4*)(io + (size_t)r * DM);
        f32x4 v[8]; float ss = 0.f;
#pragma unroll
        for (int j = 0; j < 8; ++j) { v[j] = s[lane + 64 * j]; ss += v[j][0] * v[j][0] + v[j][1] * v[j][1] + v[j][2] * v[j][2] + v[j][3] * v[j][3]; }
#pragma unroll
        for (int o = 32; o >= 1; o >>= 1) ss += __shfl_xor(ss, o);
        const float rs = rsqrtf(ss * (1.0f / 2048.0f) + 1e-6f);
#pragma unroll
        for (int j = 0; j < 8; ++j) s[lane + 64 * j] = (v[j] * rs) * ((const f32x4*)gamma)[lane + 64 * j];
    }
}

__device__ void fourier_a_phase(const bf16_t* qkv, const bf16_t* Dc, bf16_t* Y, LAS unsigned char* lds) {
    const int tid = threadIdx.x, lane = tid & 63, w = __builtin_amdgcn_readfirstlane(tid >> 6), g = lane >> 4, li = lane & 15, qq = li >> 2, pp = li & 3;
    for (int job = blockIdx.x; job < 512; job += gridDim.x) {
        const int chalf = job & 1, n2 = (job >> 1) & 127, b = job >> 8;
#pragma unroll
        for (int it = 0; it < 8; ++it) {
            const int idx = it * 512 + tid, r = idx >> 5, ch = idx & 31;
            const u32x4 v = *(const u32x4*)(qkv + ((size_t)b * SEQ + 128 * r + n2) * LDQ + OFF_F + 256 * chalf + ch * 8);
            *(LAS u32x4*)(lds + r * 528 + ch * 16) = v;
        }
        __syncthreads();
        const int k1 = 16 * w + li;
        bf16x8 db[2][4];
#pragma unroll
        for (int kd = 0; kd < 2; ++kd)
#pragma unroll
            for (int ks = 0; ks < 4; ++ks) db[kd][ks] = *(const bf16x8*)(Dc + (size_t)(kd * 128 + k1) * 128 + 32 * ks + 8 * g);
        float sn, cs; sincospif((float)((n2 * k1) & 16383) * (1.0f / 8192.0f), &sn, &cs);
        LAS unsigned char* fb = lds + (8 * g + qq) * 528 + 8 * pp;
        for (int c2 = 0; c2 < 2; ++c2) {
            f32x4 acc[8][2];
#pragma unroll
            for (int ct = 0; ct < 8; ++ct) { acc[ct][0] = (f32x4){0.f, 0.f, 0.f, 0.f}; acc[ct][1] = acc[ct][0]; }
#pragma unroll
            for (int ks = 0; ks < 4; ++ks)
#pragma unroll
                for (int ct = 0; ct < 8; ++ct) {
                    LAS unsigned char* a = fb + ks * 32 * 528 + (128 * c2 + 16 * ct) * 2;
                    const bf16x8 af = tr2(a, a + 4 * 528);
                    acc[ct][0] = mfma16(af, db[0][ks], acc[ct][0]);
                    acc[ct][1] = mfma16(af, db[1][ks], acc[ct][1]);
                }
            bf16_t* yr = Y + ((((size_t)b * 128 + k1) * 2 + 0) * 128 + n2) * 512 + 256 * chalf + 128 * c2 + 4 * g;
            bf16_t* yi = yr + (size_t)128 * 512;
#pragma unroll
            for (int ct = 0; ct < 8; ++ct) {
                const f32x4 a = acc[ct][0], bI = acc[ct][1];
                *(u32x2*)(yr + 16 * ct) = pack4(a * cs + bI * sn);
                *(u32x2*)(yi + 16 * ct) = pack4(bI * cs - a * sn);
            }
        }
        __syncthreads();
    }
}
__device__ void fourier_b_phase(const bf16_t* Y, const bf16_t* Ec, const bf16_t* MgT, const bf16_t* qkv, bf16_t* A0, LAS unsigned char* lds) {
    const int tid = threadIdx.x, lane = tid & 63, w = __builtin_amdgcn_readfirstlane(tid >> 6), g = lane >> 4, li = lane & 15, qq = li >> 2, pp = li & 3;
    for (int job = blockIdx.x; job < 1024; job += gridDim.x) {
        const int grp = job & 3, k1 = (job >> 2) & 127, b = job >> 9;
#pragma unroll
        for (int it = 0; it < 8; ++it) {
            const int idx = it * 512 + tid, r = idx >> 4, ch = idx & 15;
            const u32x4 v = *(const u32x4*)(Y + (((size_t)b * 128 + k1) * 256 + r) * 512 + 128 * grp + ch * 8);
            *(LAS u32x4*)(lds + r * 272 + ch * 16) = v;
        }
        __syncthreads();
        const int k2 = 16 * w + li;
        f32x4 acc[8][2];
#pragma unroll
        for (int ct = 0; ct < 8; ++ct) { acc[ct][0] = (f32x4){0.f, 0.f, 0.f, 0.f}; acc[ct][1] = acc[ct][0]; }
        LAS unsigned char* yb = lds + (8 * g + qq) * 272 + 8 * pp;
        const bf16_t* e0 = Ec + (size_t)k2 * 256 + 8 * g;
#pragma unroll 2
        for (int ks = 0; ks < 8; ++ks) {
            const bf16x8 eb0 = *(const bf16x8*)(e0 + 32 * ks), eb1 = *(const bf16x8*)(e0 + 128 * 256 + 32 * ks);
#pragma unroll
            for (int ct = 0; ct < 8; ++ct) {
                LAS unsigned char* a = yb + ks * 32 * 272 + 32 * ct;
                const bf16x8 af = tr2(a, a + 4 * 272);
                acc[ct][0] = mfma16(af, eb0, acc[ct][0]);
                acc[ct][1] = mfma16(af, eb1, acc[ct][1]);
            }
        }
        f32x4 o2[8];
#pragma unroll
        for (int dt = 0; dt < 8; ++dt) o2[dt] = (f32x4){0.f, 0.f, 0.f, 0.f};
        const bf16_t* mg = MgT + (size_t)(grp * 128 + li) * 256 + 4 * g;
#pragma unroll
        for (int kp = 0; kp < 2; ++kp)
#pragma unroll
            for (int ks = 0; ks < 4; ++ks) {
                const bf16x8 bfr = pack8(acc[2 * ks][kp], acc[2 * ks + 1][kp]);
#pragma unroll
                for (int dt = 0; dt < 8; ++dt) {
                    const bf16_t* mp = mg + (size_t)dt * 16 * 256 + kp * 128 + 32 * ks;
                    const u32x2 lo = *(const u32x2*)mp, hi = *(const u32x2*)(mp + 16);
                    const u32x4 aw = {lo.x, lo.y, hi.x, hi.y};
                    o2[dt] = mfma16(__builtin_bit_cast(bf16x8, aw), bfr, o2[dt]);
                }
            }
        const size_t row = (size_t)b * SEQ + k1 + 128 * k2;
        const bf16_t* zp = qkv + row * LDQ + OFF_Z + 1536 + grp * 128 + 4 * g;
        bf16_t* op = A0 + row * DM + 1536 + grp * 128 + 4 * g;
#pragma unroll
        for (int dt = 0; dt < 8; ++dt) {
            const f32x4 z = unpack4(*(const u32x2*)(zp + 16 * dt));
            *(u32x2*)(op + 16 * dt) = pack4(o2[dt] * silu4(z));
        }
        __syncthreads();
    }
}

__device__ void attn_phase(const bf16_t* qkv, const bf16_t* kcvc, const float* sink, bf16_t* A0, LAS unsigned char* lds) {
    const int tid = threadIdx.x, lane = tid & 63, w = __builtin_amdgcn_readfirstlane(tid >> 6), g = lane >> 4, li = lane & 15, qq = li >> 2, pp = li & 3;
    const int sr = tid >> 3, sc8 = tid & 7;
    const int wblk = w >> 2;
    for (int it = blockIdx.x; it < 1536; it += gridDim.x) {
        const int h = it % 12, np = (it / 12) & 63, b = it / 768, kvh = h / 3;
        const size_t rowbase = (size_t)b * SEQ + np * 256 + 32 * w;
        bf16x8 qf[2][4]; float mrun[2], lrun[2]; f32x4 o[2][8];
        const float sk = sink[h] * LOG2E;
#pragma unroll
        for (int qt = 0; qt < 2; ++qt) {
            const bf16_t* qp = qkv + (rowbase + 16 * qt + li) * LDQ + h * 128 + 8 * g;
#pragma unroll
            for (int ks = 0; ks < 4; ++ks) qf[qt][ks] = *(const bf16x8*)(qp + 32 * ks);
            mrun[qt] = sk; lrun[qt] = (g == 0) ? 1.0f : 0.0f;
#pragma unroll
            for (int dt = 0; dt < 8; ++dt) o[qt][dt] = (f32x4){0.f, 0.f, 0.f, 0.f};
        }
        const int wstart = (np == 0) ? 2 : 0, wend = (np == 63) ? 6 : 8, cnt = 4 + (wend - wstart);
        u32x4 kr0, kr1, vr0, vr1;
#define ATT_LOAD(j) do { const int t_ = (j) < 4 ? (j) : (j) - 4 + wstart; const bf16_t* kp_; \
            if ((j) < 4) kp_ = kcvc + ((size_t)b * 256 + 64 * t_ + sr) * 1024 + kvh * 128; \
            else kp_ = qkv + ((size_t)b * SEQ + np * 256 - 128 + t_ * 64 + sr) * LDQ + OFF_K + kvh * 128; \
            kr0 = *(const u32x4*)(kp_ + sc8 * 8); kr1 = *(const u32x4*)(kp_ + 64 + sc8 * 8); vr0 = *(const u32x4*)(kp_ + 512 + sc8 * 8); vr1 = *(const u32x4*)(kp_ + 512 + 64 + sc8 * 8); } while (0)
#define ATT_STORE(buf) do { LAS unsigned char* kd_ = lds + (buf) * 17408 + sr * 272 + sc8 * 16; \
            *(LAS u32x4*)kd_ = kr0; *(LAS u32x4*)(kd_ + 128) = kr1; *(LAS u32x4*)(kd_ + 34816) = vr0; *(LAS u32x4*)(kd_ + 34816 + 128) = vr1; } while (0)
        ATT_LOAD(0); ATT_STORE(0);
        __syncthreads();
        for (int j = 0; j < cnt; ++j) {
            if (j + 1 < cnt) ATT_LOAD(j + 1);
            const int tw = j - 4 + wstart;
            const int trel = tw - 2 * wblk;
            const bool active = (j < 4) || (trel >= 0 && trel < 6);
            if (active) {
                const bool needmask = (j >= 4) && (trel < 2 || trel >= 4);
                const int kpos0 = np * 256 - 128 + tw * 64;
                LAS unsigned char* kb = lds + (j & 1) * 17408;
                LAS unsigned char* vb = kb + 34816;
                f32x4 s[2][4];
#pragma unroll
                for (int qt = 0; qt < 2; ++qt)
#pragma unroll
                    for (int kt = 0; kt < 4; ++kt) s[qt][kt] = (f32x4){0.f, 0.f, 0.f, 0.f};
#pragma unroll
                for (int ks = 0; ks < 4; ++ks)
#pragma unroll
                    for (int kt = 0; kt < 4; ++kt) {
                        const bf16x8 kf = *(const LAS bf16x8*)(kb + (16 * kt + li) * 272 + (32 * ks + 8 * g) * 2);
#pragma unroll
                        for (int qt = 0; qt < 2; ++qt) s[qt][kt] = mfma16(kf, qf[qt][ks], s[qt][kt]);
                    }
                bf16x8 pf[2][2];
#pragma unroll
                for (int qt = 0; qt < 2; ++qt) {
                    if (needmask) {
                        const int qpos = np * 256 + 32 * w + 16 * qt + li;
#pragma unroll
                        for (int kt = 0; kt < 4; ++kt)
#pragma unroll
                            for (int r = 0; r < 4; ++r) { const int d = kpos0 + 16 * kt + 4 * g + r - qpos; if (d > 128 || d < -128) s[qt][kt][r] = -INFINITY; }
                    }
                    float mx = s[qt][0][0];
#pragma unroll
                    for (int kt = 0; kt < 4; ++kt)
#pragma unroll
                        for (int r = 0; r < 4; ++r) mx = fmaxf(mx, s[qt][kt][r]);
                    mx = fmaxf(mx, __shfl_xor(mx, 16)); mx = fmaxf(mx, __shfl_xor(mx, 32));
                    const float mnew = fmaxf(mrun[qt], mx), alpha = __builtin_amdgcn_exp2f(mrun[qt] - mnew);
                    mrun[qt] = mnew;
                    float ls = 0.f;
#pragma unroll
                    for (int kt = 0; kt < 4; ++kt)
#pragma unroll
                        for (int r = 0; r < 4; ++r) { const float pe = __builtin_amdgcn_exp2f(s[qt][kt][r] - mnew); s[qt][kt][r] = pe; ls += pe; }
                    lrun[qt] = lrun[qt] * alpha + ls;
#pragma unroll
                    for (int dt = 0; dt < 8; ++dt) o[qt][dt] *= alpha;
                    pf[qt][0] = pack8(s[qt][0], s[qt][1]); pf[qt][1] = pack8(s[qt][2], s[qt][3]);
                }
#pragma unroll
                for (int ks2 = 0; ks2 < 2; ++ks2)
#pragma unroll
                    for (int dt = 0; dt < 8; ++dt) {
                        LAS unsigned char* a = vb + (32 * ks2 + 4 * g + qq) * 272 + (16 * dt + 4 * pp) * 2;
                        const bf16x8 vf = tr2(a, a + 16 * 272);
#pragma unroll
                        for (int qt = 0; qt < 2; ++qt) o[qt][dt] = mfma16(vf, pf[qt][ks2], o[qt][dt]);
                    }
            }
            if (j + 1 < cnt) ATT_STORE((j + 1) & 1);
            __syncthreads();
        }
#undef ATT_LOAD
#undef ATT_STORE
#pragma unroll
        for (int qt = 0; qt < 2; ++qt) {
            float lt = lrun[qt]; lt += __shfl_xor(lt, 16); lt += __shfl_xor(lt, 32);
            const float inv = 1.0f / lt;
            const bf16_t* zp = qkv + (rowbase + 16 * qt + li) * LDQ + OFF_Z + h * 128 + 4 * g;
            bf16_t* op = A0 + (rowbase + 16 * qt + li) * DM + h * 128 + 4 * g;
#pragma unroll
            for (int dt = 0; dt < 8; ++dt) {
                const f32x4 z = unpack4(*(const u32x2*)(zp + 16 * dt));
                *(u32x2*)(op + 16 * dt) = pack4(o[qt][dt] * inv * silu4(z));
            }
        }
    }
}

__device__ void pool_phase(const bf16_t* uz, const float* lscale, bf16_t* A1) {
    const int tid = threadIdx.x, sub = tid >> 8, colo = (tid & 255) * 8, grp = colo >> 9, half = 1 << grp;
    float ls[8];
#pragma unroll
    for (int e = 0; e < 8; ++e) ls[e] = lscale[colo + e];
    for (int job = blockIdx.x; job < 512; job += gridDim.x) {
        const int b = job >> 8, t0 = (job & 255) * 64 + sub * 32;
        const bf16_t* ub = uz + (size_t)b * SEQ * 4096 + colo;
        float S[8];
#pragma unroll
        for (int e = 0; e < 8; ++e) S[e] = 0.f;
        const int lo0 = max(t0 - half, 0), hi0 = min(t0 + half, SEQ);
        for (int j = lo0; j < hi0; ++j) {
            const u32x4 v = *(const u32x4*)(ub + (size_t)j * 4096);
            S[0] += bflo(v.x); S[1] += bfhi(v.x); S[2] += bflo(v.y); S[3] += bfhi(v.y); S[4] += bflo(v.z); S[5] += bfhi(v.z); S[6] += bflo(v.w); S[7] += bfhi(v.w);
        }
        for (int t = t0; t < t0 + 32; ++t) {
            const int lo = max(t - half, 0), hi = min(t + half, SEQ);
            const float rc = 1.0f / (float)(hi - lo);
            const u32x4 uv = *(const u32x4*)(ub + (size_t)t * 4096), zv = *(const u32x4*)(ub + (size_t)t * 4096 + 2048);
            const float u8[8] = {bflo(uv.x), bfhi(uv.x), bflo(uv.y), bfhi(uv.y), bflo(uv.z), bfhi(uv.z), bflo(uv.w), bfhi(uv.w)};
            const float z8[8] = {bflo(zv.x), bfhi(zv.x), bflo(zv.y), bfhi(zv.y), bflo(zv.z), bfhi(zv.z), bflo(zv.w), bfhi(zv.w)};
            float r8[8];
#pragma unroll
            for (int e = 0; e < 8; ++e) r8[e] = (S[e] * rc - u8[e]) * ls[e] * silu(z8[e]);
            u32x4 wv; wv.x = cvt_pk_bf16(r8[0], r8[1]); wv.y = cvt_pk_bf16(r8[2], r8[3]); wv.z = cvt_pk_bf16(r8[4], r8[5]); wv.w = cvt_pk_bf16(r8[6], r8[7]);
            *(u32x4*)(A1 + ((size_t)b * SEQ + t) * DM + colo) = wv;
            if (t + half < SEQ) {
                const u32x4 v = *(const u32x4*)(ub + (size_t)(t + half) * 4096);
                S[0] += bflo(v.x); S[1] += bfhi(v.x); S[2] += bflo(v.y); S[3] += bfhi(v.y); S[4] += bflo(v.z); S[5] += bfhi(v.z); S[6] += bflo(v.w); S[7] += bfhi(v.w);
            }
            if (t - half >= 0) {
                const u32x4 v = *(const u32x4*)(ub + (size_t)(t - half) * 4096);
                S[0] -= bflo(v.x); S[1] -= bfhi(v.x); S[2] -= bflo(v.y); S[3] -= bfhi(v.y); S[4] -= bflo(v.z); S[5] -= bfhi(v.z); S[6] -= bflo(v.w); S[7] -= bfhi(v.w);
            }
        }
    }
}

__global__ void __launch_bounds__(512, 2) fwd_mega(Params p) {
    extern __shared__ __attribute__((aligned(16))) unsigned char lds_raw[];
    LAS unsigned char* lds = (LAS unsigned char*)lds_raw;
    cg::grid_group grid = cg::this_grid();
    unsigned char* ws = p.ws;
    const float* mod = (const float*)(ws + WS_MOD);
    const f32x2* rope = (const f32x2*)(ws + WS_ROPE);
    bf16_t* Dc = (bf16_t*)(ws + WS_DC); bf16_t* Ec = (bf16_t*)(ws + WS_EC); bf16_t* MgT = (bf16_t*)(ws + WS_MGT);
    bf16_t* WtIn0 = (bf16_t*)(ws + WS_WTIN0); bf16_t* WtOut0 = (bf16_t*)(ws + WS_WTOUT0); bf16_t* WtIn1 = (bf16_t*)(ws + WS_WTIN1); bf16_t* WtOut1 = (bf16_t*)(ws + WS_WTOUT1);
    bf16_t* Wbf1 = (bf16_t*)(ws + WS_WBF1); bf16_t* WgrpT = (bf16_t*)(ws + WS_WGRPT);
    bf16_t* H = (bf16_t*)(ws + WS_H); bf16_t* HC = (bf16_t*)(ws + WS_HC); bf16_t* QKV = (bf16_t*)(ws + WS_QKV); bf16_t* KCVC = (bf16_t*)(ws + WS_KCVC);
    bf16_t* Y = (bf16_t*)(ws + WS_Y); bf16_t* AB = (bf16_t*)(ws + WS_A);
    const int G = gridDim.x, bid = blockIdx.x;

    phase0(p, lds);
    grid.sync();

    {
        const int grp = bid >> 4, wi = bid & 15;
        pg8::Gemm g{WgrpT + (size_t)(grp & 3) * 262144, Wbf1 + (grp & 3) * 512, 512, 2048, 512, 512, 2048};
        OneUnit S{bid < 64 ? 1 : 0, {wi >> 3, wi & 7}};
        EpiB<0> E{WtIn1 + (size_t)(grp & 3) * 512 * 2048, 2048, nullptr};
        pg8::gemm_phase<EpiB<0>, OneUnit, false>(lds, g, S, E, nullptr);
    }
    norm_mod_phase(p.x, H, p.l0_norm, mod, p.ctx, HC);
    grid.sync();

    {
        pg8::Gemm g{H, WtIn0, MTOK, 5120, 2048, 2048, 2048}; pg8::StaticOrder S; S.init(MTOK, 5120, G, bid);
        EpiB<1> E{QKV, LDQ, rope};
        pg8::gemm_phase<EpiB<1>, pg8::StaticOrder, false>(lds, g, S, E, nullptr);
    }
    grid.sync();

    {
        pg8::Gemm g{HC, WtIn0 + (size_t)OFF_K * 2048, 512, 1024, 2048, 2048, 2048}; pg8::StaticOrder S; S.init(512, 1024, G, bid);
        EpiB<0> E{KCVC, 1024, nullptr};
        pg8::gemm_phase<EpiB<0>, pg8::StaticOrder, false>(lds, g, S, E, nullptr);
    }
    fourier_a_phase(QKV, Dc, Y, lds);
    grid.sync();

    attn_phase(QKV, KCVC, p.l0_sink, AB, lds);
    fourier_b_phase(Y, Ec, MgT, QKV, AB, lds);
    grid.sync();

    {
        pg8::Gemm g{AB, WtOut0, MTOK, 2048, 2048, 2048, 2048}; pg8::StaticOrder S; S.init(MTOK, 2048, G, bid);
        EpiRes E{p.x, p.out, mod + 4096};
        pg8::gemm_phase<EpiRes, pg8::StaticOrder, false>(lds, g, S, E, nullptr);
    }
    grid.sync();

    norm_mod_phase(p.out, H, p.l1_norm, mod + 3 * 6144, nullptr, nullptr);
    grid.sync();

    {
        pg8::Gemm g{H, WtIn1, MTOK, 4096, 2048, 2048, 2048}; pg8::StaticOrder S; S.init(MTOK, 4096, G, bid);
        EpiB<0> E{QKV, 4096, nullptr};
        pg8::gemm_phase<EpiB<0>, pg8::StaticOrder, false>(lds, g, S, E, nullptr);
    }
    grid.sync();

    pool_phase(QKV, p.l1_scale, AB);
    grid.sync();

    {
        pg8::Gemm g{AB, WtOut1, MTOK, 2048, 2048, 2048, 2048}; pg8::StaticOrder S; S.init(MTOK, 2048, G, bid);
        EpiRes E{p.out, p.out, mod + 3 * 6144 + 4096};
        pg8::gemm_phase<EpiRes, pg8::StaticOrder, false>(lds, g, S, E, nullptr);
    }
    grid.sync();

    final_norm_phase(p.out, p.final_norm);
}

extern "C" void kernel_launch(void* const* d_in, const int* in_sizes, int n_in, void* d_out, int out_size, void* d_ws, size_t ws_size, hipStream_t stream) {
    static int grid_blocks = 0;
    if (!grid_blocks) {
        int dev = 0, cus = 0, per_cu = 0;
        (void)hipGetDevice(&dev);
        (void)hipDeviceGetAttribute(&cus, hipDeviceAttributeMultiprocessorCount, dev);
        (void)hipFuncSetAttribute((const void*)fwd_mega, hipFuncAttributeMaxDynamicSharedMemorySize, LDS_BYTES);
        (void)hipOccupancyMaxActiveBlocksPerMultiprocessor(&per_cu, (const void*)fwd_mega, 512, LDS_BYTES);
        if (per_cu < 1) per_cu = 1;
        grid_blocks = cus * per_cu;
        if (ws_size < WS_END) fprintf(stderr, "kernel_launch: workspace too small (%zu < %zu)\n", ws_size, (size_t)WS_END);
    }
    Params p{};
    p.x = (const float*)d_in[0]; p.c = (const float*)d_in[1]; p.ctx = (const float*)d_in[2]; p.c_ctx = (const float*)d_in[3];
    p.l0_norm = (const float*)d_in[4]; p.l0_w_mod = (const float*)d_in[5]; p.l0_b_mod = (const float*)d_in[6]; p.l0_w_in = (const float*)d_in[7];
    p.l0_sink = (const float*)d_in[8]; p.l0_w_f = (const float*)d_in[9]; p.l0_w_out = (const float*)d_in[10];
    p.l1_norm = (const float*)d_in[11]; p.l1_w_mod = (const float*)d_in[12]; p.l1_b_mod = (const float*)d_in[13]; p.l1_w_in = (const float*)d_in[14];
    p.l1_w_grp = (const float*)d_in[15]; p.l1_scale = (const float*)d_in[16]; p.l1_w_out = (const float*)d_in[17]; p.final_norm = (const float*)d_in[18];
    p.out = (float*)d_out; p.ws = (unsigned char*)d_ws;
    void* args[] = {&p};
    hipError_t e = hipLaunchCooperativeKernel((void*)fwd_mega, dim3(grid_blocks), dim3(512), args, LDS_BYTES, stream);
    if (e != hipSuccess) fprintf(stderr, "cooperative launch failed: %s (grid %d)\n", hipGetErrorString(e), grid_blocks);
}
```

```cpp
#include <hip/hip_runtime.h>
#include <hip/hip_cooperative_groups.h>
#include <cstdio>
namespace cg = cooperative_groups;

namespace pg8 {
#define PG8_LAS __attribute__((address_space(3)))
typedef unsigned short bf16_t;
typedef short bf16x8 __attribute__((ext_vector_type(8)));
typedef float f32x4 __attribute__((ext_vector_type(4)));
typedef unsigned u32x4 __attribute__((ext_vector_type(4)));
constexpr int BM = 256, BK = 64, HALF = 128, HTB = HALF * BK * 2  , STAGE_BYTES = 8 * HTB, NXCD = 8, WGM = 8;

__host__ __device__ __forceinline__ int lds_byte(int r, int c) { const int st = (r >> 4) * 2 + (c >> 5), rr = r & 15, cc = c & 31, ob = rr * 64 + cc * 2; return st * 1024 + (ob ^ (((ob >> 9) & 1) << 5)); }
__host__ __device__ __forceinline__ void stage_rc(int b, int& R, int& C) { const int st = b / 1024, sb = b % 1024, swz = sb ^ (((sb >> 9) & 1) << 5); R = (st >> 1) * 16 + swz / 64; C = (st & 1) * 32 + (swz % 64) / 2; }
__host__ __device__ __forceinline__ int perm32(int rho) { const int n = rho >> 4, i = rho & 15; return 8 * (i >> 2) + 4 * n + (i & 3); }

struct Unit { int pm, pn; };
struct Gemm { const bf16_t* A; const bf16_t* Bt; int M, N, K, lda, ldb; };

struct StaticOrder {
    int nM, nN, nwg, G, c;
    __host__ __device__ void init(int M, int N, int G_, int c_) { nM = M / BM; nN = N / BM; nwg = nM * nN; G = G_; c = c_; }
    __host__ __device__ bool next(int i, Unit& u) const {
        const long L = (long)i * G + c; if (L >= nwg) return false;
        int wgid = (int)L; { const int q = nwg / NXCD, r = nwg % NXCD, xcd = wgid % NXCD, off = wgid / NXCD; wgid = (xcd < r ? xcd * (q + 1) : r * (q + 1) + (xcd - r) * q) + off; }
        const int nig = WGM * nN, gid = wgid / nig, fm = gid * WGM, gsz = (nM - fm) < WGM ? (nM - fm) : WGM;
        u.pm = fm + ((wgid % nig) % gsz); u.pn = (wgid % nig) / gsz; return true;
    }
    __device__ __forceinline__ void a_ready(const Unit&) const {}
    __device__ __forceinline__ void done(const Unit&) const {}
};
__device__ __forceinline__ unsigned cvt_pk_bf16(float lo, float hi) { unsigned r; asm("v_cvt_pk_bf16_f32 %0, %1, %2" : "=v"(r) : "v"(lo), "v"(hi)); return r; }
template <class Epi, class Sched, bool STAMP = false>
__device__ __forceinline__ void gemm_phase(PG8_LAS unsigned char* lds, const Gemm g, const Sched& S, const Epi& E, unsigned long long* stamps) {
    const int tid = threadIdx.x, wid = __builtin_amdgcn_readfirstlane(tid >> 6), lane = tid & 63, wr = wid >> 2, wc = wid & 3, fr = lane & 15, fq = lane >> 4;
    const int K = g.K, nt = K / BK;
    int ts_lo = 0, ts_hi = 0, nts = 0; const unsigned long long rt_entry = STAMP ? (unsigned long long)wall_clock64() : 0ull;
#define PG8_STAMP() do { if (STAMP && wid == 0 && nts < 64) { const unsigned long long _c = (unsigned long long)clock64(); \
        ts_lo = (lane == nts) ? (int)(unsigned)_c : ts_lo; ts_hi = (lane == nts) ? (int)(unsigned)(_c >> 32) : ts_hi; ++nts; } } while (0)
    PG8_STAMP();
    unsigned voffA[2], voffB[2];
#pragma unroll
    for (int i = 0; i < 2; ++i) { int R, C; stage_rc(tid * 16 + i * 8192, R, C); const int Rb = Epi::PERM ? ((R & ~31) + perm32(R & 31)) : R;
        voffA[i] = (unsigned)(R * g.lda + C) * 2u; voffB[i] = (unsigned)(Rb * g.ldb + C) * 2u; }
    const size_t kstep = (size_t)(BK * 2);
    const size_t hstepA = (size_t)HALF * g.lda * 2, hstepB = (size_t)HALF * g.ldb * 2;
    const size_t tstepA = 2 * hstepA, tstepB = 2 * hstepB;
    const unsigned ldsw = (unsigned)wid * 1024u;
    const int aoff = lds_byte(wr * 64 + fr, fq * 8), boff = lds_byte(wc * 32 + fr, fq * 8);
#define PG8_SA(b, h) (((b) * 2 + (h)) * HTB)
#define PG8_SB(b, h) ((4 + (b) * 2 + (h)) * HTB)
#define PG8_STAGE(bufoff, gbase, voff) do { _Pragma("unroll") for (int _i = 0; _i < 2; ++_i) \
        __builtin_amdgcn_global_load_lds((const unsigned*)((const char*)(gbase) + (voff)[_i]), (PG8_LAS unsigned*)(lds + (bufoff) + ldsw + _i * 8192), 16, 0, 0); } while (0)
#define PG8_LDA(dst, b, h) do { _Pragma("unroll") for (int m = 0; m < 4; ++m) _Pragma("unroll") for (int k = 0; k < 2; ++k) dst[m][k] = *(const PG8_LAS bf16x8*)(lds + PG8_SA(b, h) + aoff + m * 2048 + k * 1024); } while (0)
#define PG8_LDB(dst, b, h) do { _Pragma("unroll") for (int n = 0; n < 2; ++n) _Pragma("unroll") for (int k = 0; k < 2; ++k) dst[n][k] = *(const PG8_LAS bf16x8*)(lds + PG8_SB(b, h) + boff + n * 2048 + k * 1024); } while (0)
#define PG8_MMA(ai, bj, At, Bt) do { __builtin_amdgcn_s_setprio(1); _Pragma("unroll") for (int m = 0; m < 4; ++m) _Pragma("unroll") for (int n = 0; n < 2; ++n) _Pragma("unroll") for (int k = 0; k < 2; ++k) \
        acc[ai][bj][m][n] = __builtin_amdgcn_mfma_f32_16x16x32_bf16(Bt[n][k], At[m][k], acc[ai][bj][m][n], 0, 0, 0); __builtin_amdgcn_s_setprio(0); } while (0)
#define PG8_WAIT_V(n) asm volatile("s_waitcnt vmcnt(" #n ")" ::: "memory")
#define PG8_WAIT_L(n) asm volatile("s_waitcnt lgkmcnt(" #n ")" ::: "memory")
#define PG8_BAR __builtin_amdgcn_s_barrier()
#define PG8_SCHED __builtin_amdgcn_sched_barrier(0)
    Unit cur, nxt; int ui = 0;
    if (!S.next(0, cur)) return;
    f32x4 acc[2][2][4][2];
#pragma unroll
    for (int a = 0; a < 2; ++a)
#pragma unroll
        for (int b = 0; b < 2; ++b)
#pragma unroll
            for (int m = 0; m < 4; ++m)
#pragma unroll
                for (int n = 0; n < 2; ++n) acc[a][b][m][n] = (f32x4){0.f, 0.f, 0.f, 0.f};
    bf16x8 At[4][2], B0[2][2], B1[2][2];
    const char* cA = (const char*)g.A + (size_t)cur.pm * tstepA; const char* cB = (const char*)g.Bt + (size_t)cur.pn * tstepB;
    S.a_ready(cur);
    PG8_STAGE(PG8_SB(0, 0), cB, voffB); PG8_STAGE(PG8_SA(0, 0), cA, voffA); PG8_STAGE(PG8_SB(0, 1), cB + hstepB, voffB); PG8_STAGE(PG8_SA(0, 1), cA + hstepA, voffA);
    if (wr == 1) PG8_BAR;
    PG8_WAIT_V(4); PG8_BAR;
    PG8_STAGE(PG8_SB(1, 0), cB + kstep, voffB); PG8_STAGE(PG8_SA(1, 0), cA + kstep, voffA); PG8_STAGE(PG8_SB(1, 1), cB + hstepB + kstep, voffB);
    PG8_WAIT_V(6); PG8_BAR;
    PG8_STAMP();
    for (;;) {
        const bool has_next = S.next(ui + 1, nxt);
        const char* nA = has_next ? (const char*)g.A + (size_t)nxt.pm * tstepA : cA; const char* nB = has_next ? (const char*)g.Bt + (size_t)nxt.pn * tstepB : cB;
        for (int t = 0; t < nt; t += 2) {
            const bool last = (t == nt - 2);
            const char* a1 = cA + (size_t)(t + 1) * kstep;
            const char* a2 = last ? nA : cA + (size_t)(t + 2) * kstep; const char* b2 = last ? nB : cB + (size_t)(t + 2) * kstep;
            const char* a3 = a2 + kstep; const char* b3 = b2 + kstep;
            if (last && has_next) S.a_ready(nxt);
            PG8_LDB(B0, 0, 0); PG8_SCHED; PG8_LDA(At, 0, 0); PG8_STAGE(PG8_SA(1, 1), a1 + hstepA, voffA);
            PG8_WAIT_L(8); PG8_BAR; PG8_WAIT_L(0); PG8_MMA(0, 0, At, B0); PG8_BAR; PG8_SCHED;
            PG8_LDB(B1, 0, 1); PG8_STAGE(PG8_SB(0, 0), b2, voffB);
            PG8_BAR; PG8_WAIT_L(0); PG8_MMA(0, 1, At, B1); PG8_BAR;
            PG8_LDA(At, 0, 1); PG8_STAGE(PG8_SA(0, 0), a2, voffA);
            PG8_BAR; PG8_WAIT_L(0); PG8_MMA(1, 0, At, B0); PG8_BAR; PG8_SCHED;
            PG8_STAGE(PG8_SB(0, 1), b2 + hstepB, voffB);
            PG8_WAIT_V(6); PG8_BAR; PG8_MMA(1, 1, At, B1); PG8_BAR;
            PG8_LDB(B0, 1, 0); PG8_SCHED; PG8_LDA(At, 1, 0); PG8_STAGE(PG8_SA(0, 1), a2 + hstepA, voffA);
            PG8_WAIT_L(8); PG8_BAR; PG8_WAIT_L(0); PG8_MMA(0, 0, At, B0); PG8_BAR; PG8_SCHED;
            PG8_LDB(B1, 1, 1); PG8_STAGE(PG8_SB(1, 0), b3, voffB);
            PG8_BAR; PG8_WAIT_L(0); PG8_MMA(0, 1, At, B1); PG8_BAR;
            PG8_LDA(At, 1, 1); PG8_STAGE(PG8_SA(1, 0), a3, voffA);
            PG8_BAR; PG8_WAIT_L(0); PG8_MMA(1, 0, At, B0); PG8_BAR; PG8_SCHED;
            PG8_STAGE(PG8_SB(1, 1), b3 + hstepB, voffB);
            PG8_WAIT_V(6); PG8_BAR; PG8_MMA(1, 1, At, B1); PG8_BAR;
        }
        PG8_STAMP();
        if constexpr (!Epi::AFTER_DRAIN) { E(acc, cur, wr, wc, fr, fq); S.done(cur); }
        PG8_STAMP();
        if (!has_next) break;
#pragma unroll
        for (int a = 0; a < 2; ++a)
#pragma unroll
            for (int b = 0; b < 2; ++b)
#pragma unroll
                for (int m = 0; m < 4; ++m)
#pragma unroll
                    for (int n = 0; n < 2; ++n) acc[a][b][m][n] = (f32x4){0.f, 0.f, 0.f, 0.f};
        cur = nxt; cA = nA; cB = nB; ++ui;
    }
    PG8_WAIT_V(0);
    if (wr == 0) PG8_BAR;
    PG8_BAR;
    if constexpr (Epi::AFTER_DRAIN) { E.fused(acc, cur, wr, wc, fr, fq, lds, wid, lane); S.done(cur); }
    PG8_STAMP();
    if (STAMP && wid == 0) { stamps[lane] = lane < nts ? (((unsigned long long)(unsigned)ts_hi << 32) | (unsigned)ts_lo) : 0ull;
        if (lane == 62) stamps[62] = rt_entry; if (lane == 63) stamps[63] = (unsigned long long)wall_clock64(); }
#undef PG8_STAMP
#undef PG8_SA
#undef PG8_SB
#undef PG8_STAGE
#undef PG8_LDA
#undef PG8_LDB
#undef PG8_MMA
#undef PG8_WAIT_V
#undef PG8_WAIT_L
#undef PG8_BAR
#undef PG8_SCHED
}
}

#define LAS __attribute__((address_space(3)))
using pg8::bf16_t; using pg8::bf16x8; using pg8::f32x4; using pg8::u32x4; using pg8::cvt_pk_bf16;
typedef short s16x4 __attribute__((ext_vector_type(4)));
typedef unsigned u32x2 __attribute__((ext_vector_type(2)));
typedef float f32x2 __attribute__((ext_vector_type(2)));

constexpr int DM = 2048, SEQ = 16384, MTOK = 32768;
constexpr int LDQ = 5120;
constexpr int OFF_K = 1536, OFF_V = 2048, OFF_F = 2560, OFF_Z = 3072;
constexpr float LOG2E = 1.4426950408889634f;
constexpr float QSCALE = 0.08838834764831845f * 1.4426950408889634f;
constexpr int LDS_BYTES = 143360;
#ifndef REP_ATT
#define REP_ATT 1
#endif
#ifndef REP_FA
#define REP_FA 1
#endif
#ifndef REP_FB
#define REP_FB 1
#endif
#ifndef REP_POOL
#define REP_POOL 1
#endif
#ifndef REP_P0
#define REP_P0 1
#endif
#ifndef REP_G0
#define REP_G0 1
#endif
#ifndef REP_P4
#define REP_P4 1
#endif
#ifndef REP_G2
#define REP_G2 1
#endif
#ifndef REP_MEM
#define REP_MEM 1
#endif

constexpr size_t WS_BAR = 0;
constexpr size_t WS_MOD = 256;
constexpr size_t WS_ROPE = WS_MOD + 147456;
constexpr size_t WS_DC = WS_ROPE + 81920;
constexpr size_t WS_EC = WS_DC + 65536;
constexpr size_t WS_MGT = WS_EC + 131072;
constexpr size_t WS_WTIN0 = WS_MGT + 262144;
constexpr size_t WS_WTOUT0 = WS_WTIN0 + 20971520;
constexpr size_t WS_WTIN1 = WS_WTOUT0 + 8388608;
constexpr size_t WS_WTOUT1 = WS_WTIN1 + 16777216;
constexpr size_t WS_WBF1 = WS_WTOUT1 + 8388608;
constexpr size_t WS_WGRPT = WS_WBF1 + 8388608;
constexpr size_t WS_H = WS_WGRPT + 2097152;
constexpr size_t WS_HC = WS_H + 134217728;
constexpr size_t WS_QKV = WS_HC + 2097152;
constexpr size_t WS_KCVC = WS_QKV + 335544320;
constexpr size_t WS_Y = WS_KCVC + 1048576;
constexpr size_t WS_A = WS_Y + 67108864;
constexpr size_t WS_RSS = WS_A + 134217728;
constexpr size_t WS_BIAS1 = WS_RSS + 131072;
constexpr size_t WS_XBAR = WS_BIAS1 + 32768;
constexpr size_t WS_END = WS_XBAR + 16384;

struct Params {
    const float *x, *c, *ctx, *c_ctx;
    const float *l0_norm, *l0_w_mod, *l0_b_mod, *l0_w_in, *l0_sink, *l0_w_f, *l0_w_out;
    const float *l1_norm, *l1_w_mod, *l1_b_mod, *l1_w_in, *l1_w_grp, *l1_scale, *l1_w_out, *final_norm;
    float* out; unsigned char* ws;
};

__device__ __forceinline__ float bflo(unsigned u) { return __uint_as_float(u << 16); }
__device__ __forceinline__ float bfhi(unsigned u) { return __uint_as_float(u & 0xffff0000u); }
__device__ __forceinline__ unsigned short f2bf(float f) { return (unsigned short)(cvt_pk_bf16(f, f) & 0xffffu); }
__device__ __forceinline__ float silu(float v) { return v * __builtin_amdgcn_rcpf(1.0f + __expf(-v)); }
__device__ __forceinline__ f32x4 mfma16(bf16x8 a, bf16x8 b, f32x4 c) { return __builtin_amdgcn_mfma_f32_16x16x32_bf16(a, b, c, 0, 0, 0); }
__device__ __forceinline__ bf16x8 tr2(LAS unsigned char* p0, LAS unsigned char* p1) {
    const s16x4 a = __builtin_amdgcn_ds_read_tr16_b64_v4i16((LAS s16x4*)p0);
    const s16x4 b = __builtin_amdgcn_ds_read_tr16_b64_v4i16((LAS s16x4*)p1);
    return __builtin_shufflevector(a, b, 0, 1, 2, 3, 4, 5, 6, 7);
}
__device__ __forceinline__ bf16x8 pack8(f32x4 a, f32x4 b) {
    u32x4 w; w.x = cvt_pk_bf16(a[0], a[1]); w.y = cvt_pk_bf16(a[2], a[3]); w.z = cvt_pk_bf16(b[0], b[1]); w.w = cvt_pk_bf16(b[2], b[3]);
    return __builtin_bit_cast(bf16x8, w);
}
__device__ __forceinline__ u32x2 pack4(f32x4 a) { u32x2 w; w.x = cvt_pk_bf16(a[0], a[1]); w.y = cvt_pk_bf16(a[2], a[3]); return w; }
__device__ __forceinline__ f32x4 unpack4(u32x2 w) { return (f32x4){bflo(w.x), bfhi(w.x), bflo(w.y), bfhi(w.y)}; }
__device__ __forceinline__ f32x4 silu4(f32x4 z) { return (f32x4){silu(z[0]), silu(z[1]), silu(z[2]), silu(z[3])}; }

template <int MODE> struct EpiB {
    static constexpr bool PERM = true, AFTER_DRAIN = false;
    bf16_t* O; int ldc; const f32x2* rope;
    __device__ __forceinline__ void operator()(const f32x4 (&acc)[2][2][4][2], const pg8::Unit& u, int wr, int wc, int fr, int fq) const {
        const int row0 = u.pm * 256 + wr * 64 + fr, col0 = u.pn * 256 + wc * 32 + 8 * fq;
#pragma unroll
        for (int ai = 0; ai < 2; ++ai)
#pragma unroll
            for (int m = 0; m < 4; ++m) {
                const int row = row0 + ai * 128 + m * 16;
                bf16_t* rowp = O + (size_t)row * ldc + col0;
#pragma unroll
                for (int bj = 0; bj < 2; ++bj) {
                    f32x4 v0 = acc[ai][bj][m][0], v1 = acc[ai][bj][m][1];
                    if (MODE == 1 && u.pn < 8) {
                        const int s = row & (SEQ - 1);
                        const int t0 = ((col0 + bj * 128) & 127) >> 1;
                        const f32x2* tp = rope + (t0 < 32 ? ((s >> 6) * 32 + t0) : ((256 + (s & 63)) * 32 + (t0 - 32)));
                        const f32x4 c01 = *(const f32x4*)tp, c23 = *(const f32x4*)(tp + 2);
                        const float sc = (u.pn < 6) ? QSCALE : 1.0f;
                        f32x4 r0, r1;
                        r0[0] = (v0[0] * c01[0] - v0[1] * c01[1]) * sc; r0[1] = (v0[1] * c01[0] + v0[0] * c01[1]) * sc;
                        r0[2] = (v0[2] * c01[2] - v0[3] * c01[3]) * sc; r0[3] = (v0[3] * c01[2] + v0[2] * c01[3]) * sc;
                        r1[0] = (v1[0] * c23[0] - v1[1] * c23[1]) * sc; r1[1] = (v1[1] * c23[0] + v1[0] * c23[1]) * sc;
                        r1[2] = (v1[2] * c23[2] - v1[3] * c23[3]) * sc; r1[3] = (v1[3] * c23[2] + v1[2] * c23[3]) * sc;
                        v0 = r0; v1 = r1;
                    }
                    u32x4 w; w.x = cvt_pk_bf16(v0[0], v0[1]); w.y = cvt_pk_bf16(v0[2], v0[3]); w.z = cvt_pk_bf16(v1[0], v1[1]); w.w = cvt_pk_bf16(v1[2], v1[3]);
                    *(u32x4*)(rowp + bj * 128) = w;
                }
            }
    }
};
struct EpiRes {
    static constexpr bool PERM = false, AFTER_DRAIN = false;
    const float* base; float* out; const float* gate;
    __device__ __forceinline__ void operator()(const f32x4 (&acc)[2][2][4][2], const pg8::Unit& u, int wr, int wc, int fr, int fq) const {
        const int row0 = u.pm * 256 + wr * 64 + fr, col0 = u.pn * 256 + wc * 32 + 4 * fq;
        const float* gp = gate + (size_t)(u.pm >> 6) * 6144 + col0;
        f32x4 gv[2][2];
#pragma unroll
        for (int bj = 0; bj < 2; ++bj)
#pragma unroll
            for (int n = 0; n < 2; ++n) gv[bj][n] = *(const f32x4*)(gp + bj * 128 + n * 16);
#pragma unroll
        for (int ai = 0; ai < 2; ++ai)
#pragma unroll
            for (int m = 0; m < 4; ++m) {
                const size_t off = (size_t)(row0 + ai * 128 + m * 16) * DM + col0;
#pragma unroll
                for (int bj = 0; bj < 2; ++bj)
#pragma unroll
                    for (int n = 0; n < 2; ++n) {
                        const f32x4 bs = *(const f32x4*)(base + off + bj * 128 + n * 16);
                        *(f32x4*)(out + off + bj * 128 + n * 16) = bs + gv[bj][n] * acc[ai][bj][m][n];
                    }
                asm volatile("" ::: "memory");
            }
    }
};
struct EpiResNext {
    static constexpr bool PERM = true, AFTER_DRAIN = false;
    const float* base; float* out; const float* gate; bf16_t* hu; const float* gnext; const float* scnext; float* rss;
    __device__ __forceinline__ void operator()(const f32x4 (&acc)[2][2][4][2], const pg8::Unit& u, int wr, int wc, int fr, int fq) const {
        const int row0 = u.pm * 256 + wr * 64 + fr, col0 = u.pn * 256 + wc * 32 + 8 * fq, b = u.pm >> 6;
        float ss[8];
#pragma unroll
        for (int i = 0; i < 8; ++i) ss[i] = 0.f;
#pragma unroll
        for (int bj = 0; bj < 2; ++bj) {
            const int col = col0 + bj * 128;
            const f32x4 gv0 = *(const f32x4*)(gate + (size_t)b * 6144 + col), gv1 = *(const f32x4*)(gate + (size_t)b * 6144 + col + 4);
#pragma unroll
            for (int ai = 0; ai < 2; ++ai)
#pragma unroll
                for (int m = 0; m < 4; ++m) {
                    const size_t off = (size_t)(row0 + ai * 128 + m * 16) * DM + col;
                    const f32x4 x0 = *(const f32x4*)(base + off) + gv0 * acc[ai][bj][m][0];
                    const f32x4 x1 = *(const f32x4*)(base + off + 4) + gv1 * acc[ai][bj][m][1];
                    *(f32x4*)(out + off) = x0; *(f32x4*)(out + off + 4) = x1;
                    ss[ai * 4 + m] += ((x0[0] * x0[0] + x0[1] * x0[1]) + (x0[2] * x0[2] + x0[3] * x0[3])) + ((x1[0] * x1[0] + x1[1] * x1[1]) + (x1[2] * x1[2] + x1[3] * x1[3]));
                    const f32x4 cf0 = *(const f32x4*)(gnext + col) * (1.0f + *(const f32x4*)(scnext + (size_t)b * 6144 + col));
                    const f32x4 cf1 = *(const f32x4*)(gnext + col + 4) * (1.0f + *(const f32x4*)(scnext + (size_t)b * 6144 + col + 4));
                    *(bf16x8*)(hu + off) = pack8(x0 * cf0, x1 * cf1);
                    if (m & 1) asm volatile("" ::: "memory");
                }
        }
#pragma unroll
        for (int i = 0; i < 8; ++i) {
            float v = ss[i]; v += __shfl_xor(v, 16); v += __shfl_xor(v, 32);
            if (fq == 0) (void)__hip_atomic_fetch_add(rss + row0 + (i >> 2) * 128 + (i & 3) * 16, v, __ATOMIC_RELAXED, __HIP_MEMORY_SCOPE_AGENT);
        }
    }
};
struct EpiBNorm {
    static constexpr bool PERM = true, AFTER_DRAIN = false;
    bf16_t* O; int ldc; const float* rss; const float* bias;
    __device__ __forceinline__ void operator()(const f32x4 (&acc)[2][2][4][2], const pg8::Unit& u, int wr, int wc, int fr, int fq) const {
        const int row0 = u.pm * 256 + wr * 64 + fr, col0 = u.pn * 256 + wc * 32 + 8 * fq;
        const float* bp = bias + (size_t)(u.pm >> 6) * ldc + col0;
        f32x4 bv[2][2];
#pragma unroll
        for (int bj = 0; bj < 2; ++bj)
#pragma unroll
            for (int n = 0; n < 2; ++n) bv[bj][n] = *(const f32x4*)(bp + bj * 128 + 4 * n);
#pragma unroll
        for (int ai = 0; ai < 2; ++ai)
#pragma unroll
            for (int m = 0; m < 4; ++m) {
                const int row = row0 + ai * 128 + m * 16;
                const float rs = rsqrtf(rss[row] * (1.0f / 2048.0f) + 1e-6f);
                bf16_t* rowp = O + (size_t)row * ldc + col0;
#pragma unroll
                for (int bj = 0; bj < 2; ++bj) {
                    const f32x4 v0 = acc[ai][bj][m][0] * rs + bv[bj][0], v1 = acc[ai][bj][m][1] * rs + bv[bj][1];
                    u32x4 w; w.x = cvt_pk_bf16(v0[0], v0[1]); w.y = cvt_pk_bf16(v0[2], v0[3]); w.z = cvt_pk_bf16(v1[0], v1[1]); w.w = cvt_pk_bf16(v1[2], v1[3]);
                    *(u32x4*)(rowp + bj * 128) = w;
                }
            }
    }
};
struct EpiGateB {
    static constexpr bool PERM = true, AFTER_DRAIN = false;
    bf16_t* O; const float* gate;
    __device__ __forceinline__ void operator()(const f32x4 (&acc)[2][2][4][2], const pg8::Unit& u, int wr, int wc, int fr, int fq) const {
        const int row0 = u.pm * 256 + wr * 64 + fr, col0 = u.pn * 256 + wc * 32 + 8 * fq;
        const float* gp = gate + (size_t)(u.pm >> 6) * 6144 + col0;
        f32x4 gv[2][2];
#pragma unroll
        for (int bj = 0; bj < 2; ++bj)
#pragma unroll
            for (int n = 0; n < 2; ++n) gv[bj][n] = *(const f32x4*)(gp + bj * 128 + 4 * n);
#pragma unroll
        for (int ai = 0; ai < 2; ++ai)
#pragma unroll
            for (int m = 0; m < 4; ++m) {
                bf16_t* rowp = O + (size_t)(row0 + ai * 128 + m * 16) * DM + col0;
#pragma unroll
                for (int bj = 0; bj < 2; ++bj) *(bf16x8*)(rowp + bj * 128) = pack8(acc[ai][bj][m][0] * gv[bj][0], acc[ai][bj][m][1] * gv[bj][1]);
            }
    }
};
struct OneUnit {
    int has; pg8::Unit u;
    __device__ bool next(int i, pg8::Unit& o) const { if (i > 0 || !has) return false; o = u; return true; }
    __device__ __forceinline__ void a_ready(const pg8::Unit&) const {}
    __device__ __forceinline__ void done(const pg8::Unit&) const {}
};

__device__ __forceinline__ void transpose_tile(const float* W, int ldw, int k0, int n0, bf16_t* Wt, int ldt, int nd0, bool ropeperm, LAS bf16_t* tt) {
    const int tid = threadIdx.x;
#pragma unroll
    for (int it = 0; it < 8; ++it) {
        const int idx = it * 512 + tid, kk = idx >> 5, n4 = (idx & 31) * 4;
        const f32x4 v = *(const f32x4*)(W + (size_t)(k0 + kk) * ldw + n0 + n4);
#pragma unroll
        for (int e = 0; e < 4; ++e) {
            int nn = n4 + e;
            if (ropeperm) { const int hs = (nn >> 5) & 1, t = (nn & 31) + ((nn >> 6) << 5); nn = 2 * t + hs; }
            tt[nn * 132 + kk] = f2bf(v[e]);
        }
    }
    __syncthreads();
#pragma unroll
    for (int it = 0; it < 8; ++it) {
        const int idx = it * 512 + tid, nn = idx >> 5, ch = idx & 31;
        const u32x2 w = *(const LAS u32x2*)(tt + nn * 132 + ch * 4);
        *(u32x2*)(Wt + (size_t)(nd0 + nn) * ldt + k0 + ch * 4) = w;
    }
    __syncthreads();
}

__device__ void phase0(const Params& p, LAS unsigned char* lds) {
    const int tid = threadIdx.x;
    LAS float* sc = (LAS float*)lds;
    LAS float* red = (LAS float*)(lds + 24576);
    LAS float* trig = (LAS float*)(lds + 49152);
    LAS bf16_t* tt = (LAS bf16_t*)(lds + 53248);
    unsigned char* ws = p.ws;
    for (int i = tid; i < 3 * DM; i += 512) { const int r = i >> 11, k = i & 2047; const float v = r < 2 ? p.c[r * DM + k] : p.c_ctx[k]; sc[i] = silu(v); }
    if (tid < 128) { float s, c; sincospif((float)tid * (1.0f / 64.0f), &s, &c); trig[tid] = c; trig[128 + tid] = s; }
    __syncthreads();
    constexpr int J0 = 192, J1 = J0 + 640, J2 = J1 + 256, J3 = J2 + 256, J4 = J3 + 256, J5 = J4 + 64, J6 = J5 + 256, J7 = J6 + 20, J8 = J7 + 64, J9 = J8 + 128, J10 = J9 + 256, J11 = J10 + 64;
    for (int job = blockIdx.x; job < J11; job += gridDim.x) {
        if (job < J0) {
            const int L = job / 96, cc = job % 96;
            const float* wm = L ? p.l1_w_mod : p.l0_w_mod; const float* bm = L ? p.l1_b_mod : p.l0_b_mod;
            const int sub = tid & 15, rg = tid >> 4, col = cc * 64 + sub * 4;
            f32x4 a0 = {0.f, 0.f, 0.f, 0.f}, a1 = a0, a2 = a0;
            const float* wp = wm + (size_t)(rg * 64) * 6144 + col;
#pragma unroll 8
            for (int i = 0; i < 64; ++i) {
                const f32x4 w = *(const f32x4*)(wp + (size_t)i * 6144);
                const int k = rg * 64 + i;
                a0 += sc[k] * w; a1 += sc[2048 + k] * w; a2 += sc[4096 + k] * w;
            }
#pragma unroll
            for (int e = 0; e < 4; ++e) { red[(rg * 3 + 0) * 64 + sub * 4 + e] = a0[e]; red[(rg * 3 + 1) * 64 + sub * 4 + e] = a1[e]; red[(rg * 3 + 2) * 64 + sub * 4 + e] = a2[e]; }
            __syncthreads();
            if (tid < 192) {
                const int r = tid >> 6, cl = tid & 63; float s = bm[cc * 64 + cl];
                for (int g = 0; g < 32; ++g) s += red[(g * 3 + r) * 64 + cl];
                ((float*)(ws + WS_MOD))[(size_t)(L * 3 + r) * 6144 + cc * 64 + cl] = s;
            }
            __syncthreads();
        } else if (job < J1) {
            const int j = job - J0, nt = j % 40, kt = j / 40;
            transpose_tile(p.l0_w_in, 5120, kt * 128, nt * 128, (bf16_t*)(ws + WS_WTIN0), 2048, nt * 128, nt < 16, tt);
        } else if (job < J2) {
            const int j = job - J1, nt = j & 15, kt = j >> 4;
            transpose_tile(p.l0_w_out, 2048, kt * 128, nt * 128, (bf16_t*)(ws + WS_WTOUT0), 2048, nt * 128, false, tt);
        } else if (job < J3) {
            const int j = job - J2, nt = j & 15, kt = j >> 4;
            transpose_tile(p.l1_w_in, 4096, kt * 128, 2048 + nt * 128, (bf16_t*)(ws + WS_WTIN1), 2048, 2048 + nt * 128, false, tt);
        } else if (job < J4) {
            const int j = job - J3, nt = j & 15, kt = j >> 4;
            transpose_tile(p.l1_w_out, 2048, kt * 128, nt * 128, (bf16_t*)(ws + WS_WTOUT1), 2048, nt * 128, false, tt);
        } else if (job < J5) {
            const int j = job - J4, g = j >> 4, nt = j & 3, kt = (j >> 2) & 3;
            transpose_tile(p.l1_w_grp + (size_t)g * 262144, 512, kt * 128, nt * 128, (bf16_t*)(ws + WS_WGRPT) + (size_t)g * 262144, 512, nt * 128, false, tt);
        } else if (job < J6) {
            const int j = job - J5;
#pragma unroll
            for (int q = 0; q < 4; ++q) {
                const int e = (q * 512 + tid) * 8, row = j * 8 + (e >> 11), col = e & 2047;
                const float* sp = p.l1_w_in + (size_t)row * 4096 + col;
                const f32x4 v0 = *(const f32x4*)sp, v1 = *(const f32x4*)(sp + 4);
                *(bf16x8*)((bf16_t*)(ws + WS_WBF1) + (size_t)row * 2048 + col) = pack8(v0, v1);
            }
        } else if (job < J7) {
            const int e = (job - J6) * 512 + tid, pos = e >> 5, t = e & 31;
            const float pv = (float)(pos < 256 ? pos : pos - 256);
            const float inv = exp2f(-(float)t * (13.287712379549449f / 32.0f));
            float xr = pv * inv * 0.3183098861837907f;
            xr = xr - 2.0f * rintf(xr * 0.5f);
            float s, c; sincospif(xr, &s, &c);
            ((f32x2*)(ws + WS_ROPE))[e] = (f32x2){c, s};
        } else if (job < J8) {
            const int e = (job - J7) * 512 + tid, row = e >> 7, n1 = e & 127, kind = row >> 7, k1 = row & 127, ix = (k1 * n1) & 127;
            ((bf16_t*)(ws + WS_DC))[e] = f2bf(kind ? -trig[128 + ix] : trig[ix]);
        } else if (job < J9) {
            const int e = (job - J8) * 512 + tid, row = e >> 8, col = e & 255, kp = row >> 7, k2 = row & 127, kd = col >> 7, n2 = col & 127, ix = (k2 * n2) & 127;
            const float c = trig[ix], s = trig[128 + ix];
            ((bf16_t*)(ws + WS_EC))[e] = f2bf(kp == 0 ? (kd == 0 ? c : s) : (kd == 0 ? -s : c));
        } else if (job >= J10) {
            ((float*)(ws + WS_RSS))[(job - J10) * 512 + tid] = 0.f;
        } else {
            const int e = (job - J9) * 512 + tid, kc = e & 255, dp = (e >> 8) & 127, g = e >> 15, kind = kc >> 7;
            const int c = 32 * ((kc >> 5) & 3) + 16 * ((kc >> 2) & 1) + 4 * ((kc >> 3) & 3) + (kc & 3);
            const float* wf = p.l0_w_f + (size_t)g * 16384 + dp; float s = 0.f;
            for (int m = 0; m < 128; ++m) s += trig[kind * 128 + ((m * c) & 127)] * wf[m * 128];
            ((bf16_t*)(ws + WS_MGT))[(size_t)(g * 128 + dp) * 256 + kc] = f2bf(s * 6.905339660024878e-4f);
        }
    }
}

__device__ __forceinline__ void row_load8(const float* s, int lane, f32x4 (&v)[8]) {
#pragma unroll
    for (int j = 0; j < 8; ++j) v[j] = ((const f32x4*)s)[lane + 64 * j];
}
__device__ __forceinline__ float row_rstd(const f32x4 (&v)[8]) {
    float ss = 0.f;
#pragma unroll
    for (int j = 0; j < 8; ++j) ss += (v[j][0] * v[j][0] + v[j][1] * v[j][1]) + (v[j][2] * v[j][2] + v[j][3] * v[j][3]);
#pragma unroll
    for (int o = 32; o >= 1; o >>= 1) ss += __shfl_xor(ss, o);
    return rsqrtf(ss * (1.0f / 2048.0f) + 1e-6f);
}
struct NormArgs { const float* src; bf16_t* dst; const float* gamma; const float* modL; const float* ctx; bf16_t* hc; };
__device__ __forceinline__ const float* nm_src(const NormArgs& a, int r) { return r < MTOK ? a.src + (size_t)r * DM : a.ctx + (size_t)(r - MTOK) * DM; }
__device__ __forceinline__ void nm_finish(const NormArgs& a, int r, int lane, const f32x4 (&v)[8]) {
    bf16_t* d = r < MTOK ? a.dst + (size_t)r * DM : a.hc + (size_t)(r - MTOK) * DM;
    const float* mr = a.modL + (r < MTOK ? (r >> 14) : 2) * 6144;
    const float rs = row_rstd(v);
#pragma unroll
    for (int j = 0; j < 8; ++j) {
        const int c4 = lane + 64 * j;
        const f32x4 g = ((const f32x4*)a.gamma)[c4], sh = ((const f32x4*)mr)[c4], scl = ((const f32x4*)mr)[512 + c4];
        const f32x4 y = (v[j] * rs) * g * (1.0f + scl) + sh;
        *(u32x2*)(d + 4 * c4) = pack4(y);
    }
}
__device__ void norm_mod_phase(const float* src, bf16_t* dst, const float* gamma, const float* modL, const float* ctx, bf16_t* hc) {
    const int lane = threadIdx.x & 63, gw = blockIdx.x * 8 + (threadIdx.x >> 6), nw = gridDim.x * 8;
    const int total = ctx ? MTOK + 512 : MTOK;
    const NormArgs a{src, dst, gamma, modL, ctx, hc};
#ifdef REP_NORM
    for (int rep = 1; rep < REP_NORM; ++rep) { f32x4 vt[8]; for (int rr = gw; rr < total; rr += nw) { row_load8(nm_src(a, rr), lane, vt); nm_finish(a, rr, lane, vt); } }
#endif
    f32x4 va[8], vb[8];
    int r = gw;
    if (r < total) row_load8(nm_src(a, r), lane, va);
    while (r < total) {
        const int r2 = r + nw;
        if (r2 < total) row_load8(nm_src(a, r2), lane, vb);
        nm_finish(a, r, lane, va);
        if (r2 >= total) break;
        const int r3 = r2 + nw;
        if (r3 < total) row_load8(nm_src(a, r3), lane, va);
        nm_finish(a, r2, lane, vb);
        r = r3;
    }
}
__device__ __forceinline__ void fn_finish(float* io, const bf16_t* delta, const float* gamma, int r, int lane, f32x4 (&v)[8], const u32x2 (&dv)[8]) {
    f32x4* s = (f32x4*)(io + (size_t)r * DM);
#pragma unroll
    for (int j = 0; j < 8; ++j) v[j] += unpack4(dv[j]);
    const float rs = row_rstd(v);
#pragma unroll
    for (int j = 0; j < 8; ++j) s[lane + 64 * j] = (v[j] * rs) * ((const f32x4*)gamma)[lane + 64 * j];
}
__device__ __forceinline__ void drow_load8(const bf16_t* s, int lane, u32x2 (&v)[8]) {
#pragma unroll
    for (int j = 0; j < 8; ++j) v[j] = ((const u32x2*)s)[lane + 64 * j];
}
__device__ void final_norm_phase(float* io, const bf16_t* delta, const float* gamma) {
    const int lane = threadIdx.x & 63, gw = blockIdx.x * 8 + (threadIdx.x >> 6), nw = gridDim.x * 8;
    f32x4 va[8], vb[8]; u32x2 da[8], db[8];
    int r = gw;
    if (r < MTOK) { row_load8(io + (size_t)r * DM, lane, va); drow_load8(delta + (size_t)r * DM, lane, da); }
    while (r < MTOK) {
        const int r2 = r + nw;
        if (r2 < MTOK) { row_load8(io + (size_t)r2 * DM, lane, vb); drow_load8(delta + (size_t)r2 * DM, lane, db); }
        fn_finish(io, delta, gamma, r, lane, va, da);
        if (r2 >= MTOK) break;
        const int r3 = r2 + nw;
        if (r3 < MTOK) { row_load8(io + (size_t)r3 * DM, lane, va); drow_load8(delta + (size_t)r3 * DM, lane, da); }
        fn_finish(io, delta, gamma, r2, lane, vb, db);
        r = r3;
    }
}

__device__ void bias1_phase(const bf16_t* Wt, const float* mod1, float* bias) {
    const int lane = threadIdx.x & 63, gw = blockIdx.x * 8 + (threadIdx.x >> 6), nw = gridDim.x * 8;
    for (int col = gw; col < 4096; col += nw) {
        float s0 = 0.f, s1 = 0.f;
#pragma unroll
        for (int j = 0; j < 4; ++j) {
            const int k = (j * 64 + lane) * 8;
            const u32x4 wv = *(const u32x4*)(Wt + (size_t)col * 2048 + k);
            const float w8[8] = {bflo(wv.x), bfhi(wv.x), bflo(wv.y), bfhi(wv.y), bflo(wv.z), bfhi(wv.z), bflo(wv.w), bfhi(wv.w)};
            const f32x4 a0 = *(const f32x4*)(mod1 + k), a1 = *(const f32x4*)(mod1 + k + 4), b0 = *(const f32x4*)(mod1 + 6144 + k), b1 = *(const f32x4*)(mod1 + 6144 + k + 4);
            s0 += w8[0] * a0[0] + w8[1] * a0[1] + w8[2] * a0[2] + w8[3] * a0[3] + w8[4] * a1[0] + w8[5] * a1[1] + w8[6] * a1[2] + w8[7] * a1[3];
            s1 += w8[0] * b0[0] + w8[1] * b0[1] + w8[2] * b0[2] + w8[3] * b0[3] + w8[4] * b1[0] + w8[5] * b1[1] + w8[6] * b1[2] + w8[7] * b1[3];
        }
#pragma unroll
        for (int o = 32; o >= 1; o >>= 1) { s0 += __shfl_xor(s0, o); s1 += __shfl_xor(s1, o); }
        if (lane == 0) { bias[col] = s0; bias[4096 + col] = s1; }
    }
}

__device__ void fourier_a_phase(const bf16_t* qkv, const bf16_t* Dc, bf16_t* Y, LAS unsigned char* lds) {
    const int tid = threadIdx.x, lane = tid & 63, w = __builtin_amdgcn_readfirstlane(tid >> 6), g = lane >> 4, li = lane & 15, qq = li >> 2, pp = li & 3;
    const int k1 = 16 * w + li;
    bf16x8 db[2][4];
#pragma unroll
    for (int kd = 0; kd < 2; ++kd)
#pragma unroll
        for (int ks = 0; ks < 4; ++ks) db[kd][ks] = *(const bf16x8*)(Dc + (size_t)(kd * 128 + k1) * 128 + 32 * ks + 8 * g);
    const int fa_first = (gridDim.x > 64) ? (int)blockIdx.x - 8 : (int)blockIdx.x, fa_step = (gridDim.x > 64) ? (int)gridDim.x - 8 : (int)gridDim.x;
    for (int job0 = (fa_first < 0) ? 512 * REP_FA : fa_first; job0 < 512 * REP_FA; job0 += fa_step) {
        const int job = job0 & 511;
        const int chalf = job & 1, n2 = (job >> 1) & 127, b = job >> 8;
#pragma unroll
        for (int it = 0; it < 8; ++it) {
            const int idx = it * 512 + tid, r = idx >> 5, ch = idx & 31;
            const u32x4 v = *(const u32x4*)(qkv + ((size_t)b * SEQ + 128 * r + n2) * LDQ + OFF_F + 256 * chalf + ch * 8);
            *(LAS u32x4*)(lds + r * 528 + ch * 16) = v;
        }
        __syncthreads();
        float sn, cs; sincospif((float)((n2 * k1) & 16383) * (1.0f / 8192.0f), &sn, &cs);
        LAS unsigned char* fb = lds + (8 * g + qq) * 528 + 16 * pp;
        for (int c2 = 0; c2 < 2; ++c2) {
            f32x4 acc[8][2];
#pragma unroll
            for (int ct = 0; ct < 8; ++ct) { acc[ct][0] = (f32x4){0.f, 0.f, 0.f, 0.f}; acc[ct][1] = acc[ct][0]; }
#pragma unroll
            for (int ks = 0; ks < 4; ++ks)
#pragma unroll
                for (int ct = 0; ct < 8; ++ct) {
                    LAS unsigned char* a = fb + ks * 32 * 528 + (128 * c2 + 32 * (ct >> 1) + 4 * (ct & 1)) * 2;
                    const bf16x8 af = tr2(a, a + 4 * 528);
                    acc[ct][0] = mfma16(af, db[0][ks], acc[ct][0]);
                    acc[ct][1] = mfma16(af, db[1][ks], acc[ct][1]);
                }
            bf16_t* yr = Y + ((((size_t)b * 128 + k1) * 2 + 0) * 128 + n2) * 512 + 256 * chalf + 128 * c2 + 8 * g;
            bf16_t* yi = yr + (size_t)128 * 512;
#pragma unroll
            for (int k = 0; k < 4; ++k) {
                const f32x4 a0 = acc[2 * k][0], b0 = acc[2 * k][1], a1 = acc[2 * k + 1][0], b1 = acc[2 * k + 1][1];
                *(bf16x8*)(yr + 32 * k) = pack8(a0 * cs + b0 * sn, a1 * cs + b1 * sn);
                *(bf16x8*)(yi + 32 * k) = pack8(b0 * cs - a0 * sn, b1 * cs - a1 * sn);
            }
        }
        __syncthreads();
    }
}
__device__ void fourier_b_phase(const bf16_t* Y, const bf16_t* Ec, const bf16_t* MgT, const bf16_t* qkv, bf16_t* A0, LAS unsigned char* lds) {
    const int tid = threadIdx.x, lane = tid & 63, w = __builtin_amdgcn_readfirstlane(tid >> 6), g = lane >> 4, li = lane & 15, qq = li >> 2, pp = li & 3;
    const bool mlds = (gridDim.x & 3) == 0;
    LAS unsigned char* ms = lds + 69632;
    if (mlds) {
#pragma unroll
        for (int it = 0; it < 8; ++it) {
            const int idx = it * 512 + tid, r = idx >> 5, ch = idx & 31;
            *(LAS u32x4*)(ms + r * 528 + ch * 16) = *(const u32x4*)(MgT + (size_t)((blockIdx.x & 3) * 128 + r) * 256 + ch * 8);
        }
    }
    for (int job0 = blockIdx.x; job0 < 1024 * REP_FB; job0 += gridDim.x) {
        const int job = job0 & 1023;
        const int grp = job & 3, k1 = (job >> 2) & 127, b = job >> 9;
#pragma unroll
        for (int it = 0; it < 8; ++it) {
            const int idx = it * 512 + tid, r = idx >> 4, ch = idx & 15;
            const u32x4 v = *(const u32x4*)(Y + (((size_t)b * 128 + k1) * 256 + r) * 512 + 128 * grp + ch * 8);
            *(LAS u32x4*)(lds + r * 272 + ch * 16) = v;
        }
        __syncthreads();
        const int k2 = 16 * w + li;
        f32x4 acc[8][2];
#pragma unroll
        for (int ct = 0; ct < 8; ++ct) { acc[ct][0] = (f32x4){0.f, 0.f, 0.f, 0.f}; acc[ct][1] = acc[ct][0]; }
        LAS unsigned char* yb = lds + (8 * g + qq) * 272 + 8 * pp;
        const bf16_t* e0 = Ec + (size_t)k2 * 256 + 8 * g;
#pragma unroll 2
        for (int ks = 0; ks < 8; ++ks) {
            const bf16x8 eb0 = *(const bf16x8*)(e0 + 32 * ks), eb1 = *(const bf16x8*)(e0 + 128 * 256 + 32 * ks);
#pragma unroll
            for (int ct = 0; ct < 8; ++ct) {
                LAS unsigned char* a = yb + ks * 32 * 272 + 32 * ct;
                const bf16x8 af = tr2(a, a + 4 * 272);
                acc[ct][0] = mfma16(af, eb0, acc[ct][0]);
                acc[ct][1] = mfma16(af, eb1, acc[ct][1]);
            }
        }
        f32x4 o2[8];
#pragma unroll
        for (int dt = 0; dt < 8; ++dt) o2[dt] = (f32x4){0.f, 0.f, 0.f, 0.f};
        const bf16_t* mg = MgT + (size_t)(grp * 128 + 8 * (li >> 2) + (li & 3)) * 256 + 8 * g;
#pragma unroll
        for (int kp = 0; kp < 2; ++kp)
#pragma unroll
            for (int ks = 0; ks < 4; ++ks) {
                const bf16x8 bfr = pack8(acc[2 * ks][kp], acc[2 * ks + 1][kp]);
#pragma unroll
                for (int dt = 0; dt < 8; ++dt) {
                    const bf16x8 af = mlds ? *(const LAS bf16x8*)(ms + (8 * (li >> 2) + (li & 3) + 32 * (dt >> 1) + 4 * (dt & 1)) * 528 + (kp * 4 + ks) * 64 + 16 * g)
                                           : *(const bf16x8*)(mg + (size_t)(32 * (dt >> 1) + 4 * (dt & 1)) * 256 + (kp * 4 + ks) * 32);
                    o2[dt] = mfma16(af, bfr, o2[dt]);
                }
            }
        const size_t row = (size_t)b * SEQ + k1 + 128 * k2;
        const bf16_t* zp = qkv + row * LDQ + OFF_Z + 1536 + grp * 128 + 8 * g;
        bf16_t* op = A0 + row * DM + 1536 + grp * 128 + 8 * g;
#pragma unroll
        for (int k = 0; k < 4; ++k) {
            const u32x4 zv = *(const u32x4*)(zp + 32 * k);
            const f32x4 z0 = unpack4((u32x2){zv.x, zv.y}), z1 = unpack4((u32x2){zv.z, zv.w});
            *(bf16x8*)(op + 32 * k) = pack8(o2[2 * k] * silu4(z0), o2[2 * k + 1] * silu4(z1));
        }
        __syncthreads();
    }
}

__device__ void attn_phase(const bf16_t* qkv, const bf16_t* kcvc, const float* sink, bf16_t* A0, LAS unsigned char* lds) {
    const int tid = threadIdx.x, lane = tid & 63, w = __builtin_amdgcn_readfirstlane(tid >> 6), g = lane >> 4, li = lane & 15, qq = li >> 2, pp = li & 3;
    const int sr = tid >> 2, sc4 = tid & 3;
    for (int it0 = blockIdx.x; it0 < 1536 * REP_ATT; it0 += gridDim.x) {
        const int it = it0 % 1536;
        const int h = it % 12, np = (it / 12) & 63, b = it / 768, kvh = h / 3;
        const size_t rowbase = (size_t)b * SEQ + np * 256 + 32 * w;
        bf16x8 qf[2][4]; float mrun[2], lrun[2]; f32x4 o[2][8];
        const float sk = sink[h] * LOG2E;
#pragma unroll
        for (int qt = 0; qt < 2; ++qt) {
            const bf16_t* qp = qkv + (rowbase + 16 * qt + li) * LDQ + h * 128 + 8 * g;
#pragma unroll
            for (int ks = 0; ks < 4; ++ks) qf[qt][ks] = *(const bf16x8*)(qp + 32 * ks);
            mrun[qt] = sk; lrun[qt] = (g == 0) ? 1.0f : 0.0f;
#pragma unroll
            for (int dt = 0; dt < 8; ++dt) o[qt][dt] = (f32x4){0.f, 0.f, 0.f, 0.f};
        }
        const int wstart = (np == 0) ? 1 : 0, wend = (np == 63) ? 3 : 4, cnt = 2 + (wend - wstart);
        u32x4 kr[4], vr[4];
#define ATT_LOAD(j) do { const bf16_t* kp_; \
            if ((j) < 2) kp_ = kcvc + ((size_t)b * 256 + 128 * (j) + sr) * 1024 + kvh * 128; \
            else kp_ = qkv + ((size_t)b * SEQ + np * 256 - 128 + ((j) - 2 + wstart) * 128 + sr) * LDQ + OFF_K + kvh * 128; \
            _Pragma("unroll") for (int i_ = 0; i_ < 4; ++i_) { kr[i_] = *(const u32x4*)(kp_ + (sc4 + 4 * i_) * 8); vr[i_] = *(const u32x4*)(kp_ + 512 + (sc4 + 4 * i_) * 8); } } while (0)
#define ATT_STORE(buf) do { LAS unsigned char* kd_ = lds + (buf) * 34816 + sr * 272 + sc4 * 16; LAS unsigned char* vd_ = lds + 69632 + (buf) * 36864 + sr * 288 + sc4 * 16; \
            _Pragma("unroll") for (int i_ = 0; i_ < 4; ++i_) { *(LAS u32x4*)(kd_ + 64 * i_) = kr[i_]; *(LAS u32x4*)(vd_ + 64 * i_) = vr[i_]; } } while (0)
        ATT_LOAD(0); ATT_STORE(0);
        __syncthreads();
        for (int j2 = 0; j2 < cnt; ++j2) {
            if (j2 + 1 < cnt) ATT_LOAD(j2 + 1);
#pragma unroll 1
          for (int hf = 0; hf < 2; ++hf) {
            const int tw = 2 * (j2 - 2 + wstart) + hf;
            const int kpos0 = np * 256 - 128 + tw * 64;
            const int q0 = np * 256 + 32 * w;
            const bool active = (j2 < 2) || (kpos0 + 63 >= q0 - 128 && kpos0 <= q0 + 31 + 128);
            if (active) {
                const bool needmask = (j2 >= 2) && !(kpos0 >= q0 + 31 - 128 && kpos0 + 63 <= q0 + 128);
                LAS unsigned char* kb = lds + (j2 & 1) * 34816 + hf * (64 * 272);
                LAS unsigned char* vb = lds + 69632 + (j2 & 1) * 36864 + hf * (64 * 288);
                f32x4 s[2][4];
#pragma unroll
                for (int qt = 0; qt < 2; ++qt)
#pragma unroll
                    for (int kt = 0; kt < 4; ++kt) s[qt][kt] = (f32x4){0.f, 0.f, 0.f, 0.f};
#pragma unroll
                for (int ks = 0; ks < 4; ++ks)
#pragma unroll
                    for (int kt = 0; kt < 4; ++kt) {
                        const bf16x8 kf = *(const LAS bf16x8*)(kb + (16 * kt + li) * 272 + (32 * ks + 8 * g) * 2);
#pragma unroll
                        for (int qt = 0; qt < 2; ++qt) s[qt][kt] = mfma16(kf, qf[qt][ks], s[qt][kt]);
                    }
                bf16x8 pf[2][2];
#pragma unroll
                for (int qt = 0; qt < 2; ++qt) {
                    if (needmask) {
                        const int qpos = np * 256 + 32 * w + 16 * qt + li;
#pragma unroll
                        for (int kt = 0; kt < 4; ++kt)
#pragma unroll
                            for (int r = 0; r < 4; ++r) { const int d = kpos0 + 16 * kt + 4 * g + r - qpos; if (d > 128 || d < -128) s[qt][kt][r] = -INFINITY; }
                    }
                    float mx = s[qt][0][0];
#pragma unroll
                    for (int kt = 0; kt < 4; ++kt)
#pragma unroll
                        for (int r = 0; r < 4; ++r) mx = fmaxf(mx, s[qt][kt][r]);
                    if (__builtin_amdgcn_ballot_w64(mx > mrun[qt] + 8.0f) != 0ull) {
                        mx = fmaxf(mx, __shfl_xor(mx, 16)); mx = fmaxf(mx, __shfl_xor(mx, 32));
                        const bool grow = mx > mrun[qt] + 8.0f;
                        const float mnew = grow ? mx : mrun[qt], alpha = __builtin_amdgcn_exp2f(mrun[qt] - mnew);
                        mrun[qt] = mnew; lrun[qt] *= alpha;
#pragma unroll
                        for (int dt = 0; dt < 8; ++dt) o[qt][dt] *= alpha;
                    }
                    const float mcur = mrun[qt];
                    float ls = 0.f;
#pragma unroll
                    for (int kt = 0; kt < 4; ++kt)
#pragma unroll
                        for (int r = 0; r < 4; ++r) { const float pe = __builtin_amdgcn_exp2f(s[qt][kt][r] - mcur); s[qt][kt][r] = pe; ls += pe; }
                    lrun[qt] += ls;
                    pf[qt][0] = pack8(s[qt][0], s[qt][1]); pf[qt][1] = pack8(s[qt][2], s[qt][3]);
                }
#pragma unroll
                for (int ks2 = 0; ks2 < 2; ++ks2)
#pragma unroll
                    for (int dt = 0; dt < 8; ++dt) {
                        LAS unsigned char* a = vb + (32 * ks2 + 4 * g + qq) * 288 + (32 * (dt >> 1) + 8 * pp + 4 * (dt & 1)) * 2;
                        const bf16x8 vf = tr2(a, a + 16 * 288);
#pragma unroll
                        for (int qt = 0; qt < 2; ++qt) o[qt][dt] = mfma16(vf, pf[qt][ks2], o[qt][dt]);
                    }
            }
          }
            if (j2 + 1 < cnt) ATT_STORE((j2 + 1) & 1);
            __syncthreads();
        }
#undef ATT_LOAD
#undef ATT_STORE
#pragma unroll
        for (int qt = 0; qt < 2; ++qt) {
            float lt = lrun[qt]; lt += __shfl_xor(lt, 16); lt += __shfl_xor(lt, 32);
            const float inv = 1.0f / lt;
            const bf16_t* zp = qkv + (rowbase + 16 * qt + li) * LDQ + OFF_Z + h * 128 + 8 * g;
            bf16_t* op = A0 + (rowbase + 16 * qt + li) * DM + h * 128 + 8 * g;
#pragma unroll
            for (int k = 0; k < 4; ++k) {
                const u32x4 zv = *(const u32x4*)(zp + 32 * k);
                const f32x4 z0 = unpack4((u32x2){zv.x, zv.y}), z1 = unpack4((u32x2){zv.z, zv.w});
                *(bf16x8*)(op + 32 * k) = pack8(o[qt][2 * k] * inv * silu4(z0), o[qt][2 * k + 1] * inv * silu4(z1));
            }
        }
    }
}

__device__ void pool_phase(const bf16_t* uz, const float* lscale, bf16_t* A1) {
    const int tid = threadIdx.x, sub = tid >> 8, colo = (tid & 255) * 8, grp = colo >> 9, half = 1 << grp;
    float ls[8];
#pragma unroll
    for (int e = 0; e < 8; ++e) ls[e] = lscale[colo + e];
    for (int job0 = blockIdx.x; job0 < 512 * REP_POOL; job0 += gridDim.x) {
        const int job = job0 & 511;
        const int b = job >> 8, t0 = (job & 255) * 64 + sub * 32;
        const bf16_t* ub = uz + (size_t)b * SEQ * 4096 + colo;
        float S[8];
#pragma unroll
        for (int e = 0; e < 8; ++e) S[e] = 0.f;
        const int lo0 = max(t0 - half, 0), hi0 = min(t0 + half, SEQ);
        for (int j = lo0; j < hi0; ++j) {
            const u32x4 v = *(const u32x4*)(ub + (size_t)j * 4096);
            S[0] += bflo(v.x); S[1] += bfhi(v.x); S[2] += bflo(v.y); S[3] += bfhi(v.y); S[4] += bflo(v.z); S[5] += bfhi(v.z); S[6] += bflo(v.w); S[7] += bfhi(v.w);
        }
        for (int tc = t0; tc < t0 + 32; tc += 4) {
            u32x4 uv[4], zv[4], ua[4], us[4];
#pragma unroll
            for (int i = 0; i < 4; ++i) {
                const int t = tc + i;
                uv[i] = *(const u32x4*)(ub + (size_t)t * 4096); zv[i] = *(const u32x4*)(ub + (size_t)t * 4096 + 2048);
                ua[i] = (t + half < SEQ) ? *(const u32x4*)(ub + (size_t)(t + half) * 4096) : (u32x4){0u, 0u, 0u, 0u};
                us[i] = (t - half >= 0) ? *(const u32x4*)(ub + (size_t)(t - half) * 4096) : (u32x4){0u, 0u, 0u, 0u};
            }
#pragma unroll
            for (int i = 0; i < 4; ++i) {
                const int t = tc + i;
                const int lo = max(t - half, 0), hi = min(t + half, SEQ);
                const float rc = 1.0f / (float)(hi - lo);
                const float u8[8] = {bflo(uv[i].x), bfhi(uv[i].x), bflo(uv[i].y), bfhi(uv[i].y), bflo(uv[i].z), bfhi(uv[i].z), bflo(uv[i].w), bfhi(uv[i].w)};
                const float z8[8] = {bflo(zv[i].x), bfhi(zv[i].x), bflo(zv[i].y), bfhi(zv[i].y), bflo(zv[i].z), bfhi(zv[i].z), bflo(zv[i].w), bfhi(zv[i].w)};
                float r8[8];
#pragma unroll
                for (int e = 0; e < 8; ++e) r8[e] = (S[e] * rc - u8[e]) * ls[e] * silu(z8[e]);
                u32x4 wv; wv.x = cvt_pk_bf16(r8[0], r8[1]); wv.y = cvt_pk_bf16(r8[2], r8[3]); wv.z = cvt_pk_bf16(r8[4], r8[5]); wv.w = cvt_pk_bf16(r8[6], r8[7]);
                *(u32x4*)(A1 + ((size_t)b * SEQ + t) * DM + colo) = wv;
                S[0] += bflo(ua[i].x) - bflo(us[i].x); S[1] += bfhi(ua[i].x) - bfhi(us[i].x); S[2] += bflo(ua[i].y) - bflo(us[i].y); S[3] += bfhi(ua[i].y) - bfhi(us[i].y);
                S[4] += bflo(ua[i].z) - bflo(us[i].z); S[5] += bfhi(ua[i].z) - bfhi(us[i].z); S[6] += bflo(ua[i].w) - bflo(us[i].w); S[7] += bfhi(ua[i].w) - bfhi(us[i].w);
            }
        }
    }
}

__device__ __forceinline__ void grid_bar(unsigned* cnt, unsigned target) {
    asm volatile("s_waitcnt vmcnt(0)" ::: "memory");
    __syncthreads();
    if (threadIdx.x == 0) {
        __builtin_amdgcn_fence(__ATOMIC_RELEASE, "agent");
        asm volatile("s_waitcnt vmcnt(0)" ::: "memory");
        (void)__hip_atomic_fetch_add(cnt, 1u, __ATOMIC_RELAXED, __HIP_MEMORY_SCOPE_AGENT);
        unsigned sp = 0;
        while (__hip_atomic_load(cnt, __ATOMIC_RELAXED, __HIP_MEMORY_SCOPE_AGENT) < target) { __builtin_amdgcn_s_sleep(1); if (++sp > (1u << 24)) break; }
        __builtin_amdgcn_fence(__ATOMIC_ACQUIRE, "agent");
        asm volatile("s_waitcnt vmcnt(0)" ::: "memory");
    }
    __syncthreads();
}

#define XB_TMO      128
#define XB_XCNT(j)  (256  + 64 * (j))
#define XB_XSUB(j)  (1280 + 64 * (j))
#define XB_XGEN(j)  (2304 + 64 * (j))
#define XB_TOP      3328
#define XB_TOPGEN   3392
#define XB_SPIN_CAP (1u << 22)
__device__ __forceinline__ unsigned xb_ld(unsigned* p)              { return __hip_atomic_load(p, __ATOMIC_RELAXED, __HIP_MEMORY_SCOPE_AGENT); }
__device__ __forceinline__ unsigned xb_add(unsigned* p, unsigned v) { return __hip_atomic_fetch_add(p, v, __ATOMIC_RELAXED, __HIP_MEMORY_SCOPE_AGENT); }
__device__ __forceinline__ unsigned xb_xcc_id() { return (unsigned)__builtin_amdgcn_s_getreg((3 << 11) | 20) & 0xFu; }
#define XB_SPIN(cond, bar) do { unsigned _sp = 0; while (cond) { __builtin_amdgcn_s_sleep(1); \
    if ((++_sp & 255u) == 0u) { if (xb_ld(&(bar)[XB_TMO])) break; if (_sp > XB_SPIN_CAP) { atomicAdd(&(bar)[XB_TMO], 1u); break; } } } } while (0)
struct XcdBar { unsigned* bar; unsigned x, nloc, nx; };
__device__ __forceinline__ void xcd_bar(XcdBar& b) {
    asm volatile("s_waitcnt vmcnt(0)" ::: "memory");
    __syncthreads();
    if (threadIdx.x == 0) {
        unsigned* bar = b.bar;
        __builtin_amdgcn_s_waitcnt(0);
        if (b.nloc == 0u) {
            const unsigned G = gridDim.x; unsigned sum, cnt, mine, sp = 0u;
            for (;;) {
                sum = 0u; cnt = 0u; mine = 0u;
#pragma unroll
                for (unsigned j = 0; j < 16; ++j) { const unsigned c = xb_ld(&bar[XB_XCNT(j)]); sum += c; cnt += (c > 0u) ? 1u : 0u; mine = (j == b.x) ? c : mine; }
                if (sum == G) break;
                __builtin_amdgcn_s_sleep(1);
                if ((++sp & 255u) == 0u) { if (xb_ld(&bar[XB_TMO])) break; if (sp > XB_SPIN_CAP) { atomicAdd(&bar[XB_TMO], 1u); break; } }
            }
            b.nloc = mine > 0u ? mine : 1u; b.nx = cnt > 0u ? cnt : 1u;
        }
        const unsigned nloc = b.nloc, nx = b.nx;
        const unsigned old = xb_add(&bar[XB_XSUB(b.x)], 1u);
        const unsigned gen = old / nloc;
        if (old + 1u == (gen + 1u) * nloc) {
            __builtin_amdgcn_fence(__ATOMIC_RELEASE, "agent");
            asm volatile("s_waitcnt vmcnt(0)" ::: "memory");
            const unsigned og = xb_add(&bar[XB_TOP], 1u);
            const unsigned tg = og / nx;
            if (og + 1u == (tg + 1u) * nx) xb_add(&bar[XB_TOPGEN], 1u);
            else XB_SPIN(xb_ld(&bar[XB_TOPGEN]) == tg, bar);
            __builtin_amdgcn_fence(__ATOMIC_ACQUIRE, "agent");
            xb_add(&bar[XB_XGEN(b.x)], 1u);
            asm volatile("s_waitcnt vmcnt(0)" ::: "memory");
        } else {
            XB_SPIN(xb_ld(&bar[XB_XGEN(b.x)]) == gen, bar);
            __builtin_amdgcn_fence(__ATOMIC_ACQUIRE, "agent");
            asm volatile("s_waitcnt vmcnt(0)" ::: "memory");
        }
    }
    __syncthreads();
}

__global__ void __launch_bounds__(512, 2) fwd_mega(Params p) {
    extern __shared__ __attribute__((aligned(16))) unsigned char lds_raw[];
    LAS unsigned char* lds = (LAS unsigned char*)lds_raw;
    cg::grid_group grid = cg::this_grid();
    unsigned char* ws = p.ws;
    const float* mod = (const float*)(ws + WS_MOD);
    const f32x2* rope = (const f32x2*)(ws + WS_ROPE);
    bf16_t* Dc = (bf16_t*)(ws + WS_DC); bf16_t* Ec = (bf16_t*)(ws + WS_EC); bf16_t* MgT = (bf16_t*)(ws + WS_MGT);
    bf16_t* WtIn0 = (bf16_t*)(ws + WS_WTIN0); bf16_t* WtOut0 = (bf16_t*)(ws + WS_WTOUT0); bf16_t* WtIn1 = (bf16_t*)(ws + WS_WTIN1); bf16_t* WtOut1 = (bf16_t*)(ws + WS_WTOUT1);
    bf16_t* Wbf1 = (bf16_t*)(ws + WS_WBF1); bf16_t* WgrpT = (bf16_t*)(ws + WS_WGRPT);
    bf16_t* H = (bf16_t*)(ws + WS_H); bf16_t* HC = (bf16_t*)(ws + WS_HC); bf16_t* QKV = (bf16_t*)(ws + WS_QKV); bf16_t* KCVC = (bf16_t*)(ws + WS_KCVC);
    bf16_t* Y = (bf16_t*)(ws + WS_Y); bf16_t* AB = (bf16_t*)(ws + WS_A);
    float* RSS = (float*)(ws + WS_RSS); float* BIAS1 = (float*)(ws + WS_BIAS1);
    const int G = gridDim.x, bid = blockIdx.x;

    unsigned* barcnt = (unsigned*)(ws + WS_BAR); unsigned nbar = 0;
    XcdBar xbar; xbar.bar = (unsigned*)(ws + WS_XBAR); xbar.x = xb_xcc_id(); xbar.nloc = 0u; xbar.nx = 0u;
    if (threadIdx.x == 0) (void)xb_add(&xbar.bar[XB_XCNT(xbar.x)], 1u);
#ifdef USE_CG_SYNC
#define GRID_BAR() grid.sync()
#else
#ifdef USE_FLAT_BAR
#define GRID_BAR() do { ++nbar; grid_bar(barcnt, nbar * (unsigned)G); } while (0)
#else
#define GRID_BAR() xcd_bar(xbar)
#endif
#endif
    phase0(p, lds);
#if REP_P0 > 1
    __syncthreads(); phase0(p, lds); __syncthreads(); phase0(p, lds);
#endif
#ifdef USE_CG_SYNC
    grid.sync();
#else
    if (p.ws == nullptr) grid.sync();
    GRID_BAR();
#endif

    norm_mod_phase(p.x, H, p.l0_norm, mod, p.ctx, HC);
    GRID_BAR();

    {
        pg8::Gemm g{H, WtIn0, MTOK, 5120, 2048, 2048, 2048}; pg8::StaticOrder S; S.init(MTOK, 5120, G, bid);
        EpiB<1> E{QKV, LDQ, rope};
        pg8::gemm_phase<EpiB<1>, pg8::StaticOrder, false>(lds, g, S, E, nullptr);
#if REP_G0 > 1
        pg8::gemm_phase<EpiB<1>, pg8::StaticOrder, false>(lds, g, S, E, nullptr);
#endif
    }
    GRID_BAR();

    {
        pg8::Gemm g{HC, WtIn0 + (size_t)OFF_K * 2048, 512, 1024, 2048, 2048, 2048}; pg8::StaticOrder S; S.init(512, 1024, G, bid);
        EpiB<0> E{KCVC, 1024, nullptr};
        pg8::gemm_phase<EpiB<0>, pg8::StaticOrder, false>(lds, g, S, E, nullptr);
    }
    {
        const int fbk = (bid - 8) & 63, grp = fbk >> 4, wi = fbk & 15;
        pg8::Gemm g{WgrpT + (size_t)grp * 262144, Wbf1 + grp * 512, 512, 2048, 512, 512, 2048};
        OneUnit S{(G >= 72 ? (bid >= 8 && bid < 72) : (bid < 64)) ? 1 : 0, {wi >> 3, wi & 7}};
        EpiB<0> E{WtIn1 + (size_t)grp * 512 * 2048, 2048, nullptr};
        pg8::gemm_phase<EpiB<0>, OneUnit, false>(lds, g, S, E, nullptr);
    }
    fourier_a_phase(QKV, Dc, Y, lds);
    GRID_BAR();

    bias1_phase(WtIn1, mod + 3 * 6144, BIAS1);
    attn_phase(QKV, KCVC, p.l0_sink, AB, lds);
#if REP_P4 == 2
    attn_phase(QKV, KCVC, p.l0_sink, AB, lds);
#endif
    fourier_b_phase(Y, Ec, MgT, QKV, AB, lds);
#if REP_P4 == 3
    fourier_b_phase(Y, Ec, MgT, QKV, AB, lds);
#endif
#if REP_P4 == 4
    GRID_BAR();
    attn_phase(QKV, KCVC, p.l0_sink, AB, lds);
#endif
    GRID_BAR();

    {
        pg8::Gemm g{AB, WtOut0, MTOK, 2048, 2048, 2048, 2048}; pg8::StaticOrder S; S.init(MTOK, 2048, G, bid);
        EpiResNext E{p.x, p.out, mod + 4096, H, p.l1_norm, mod + 3 * 6144 + 2048, RSS};
        pg8::gemm_phase<EpiResNext, pg8::StaticOrder, false>(lds, g, S, E, nullptr);
    }
    GRID_BAR();

    {
        pg8::Gemm g{H, WtIn1, MTOK, 4096, 2048, 2048, 2048}; pg8::StaticOrder S; S.init(MTOK, 4096, G, bid);
        EpiBNorm E{QKV, 4096, RSS, BIAS1};
        pg8::gemm_phase<EpiBNorm, pg8::StaticOrder, false>(lds, g, S, E, nullptr);
#if REP_G2 > 1
        pg8::gemm_phase<EpiBNorm, pg8::StaticOrder, false>(lds, g, S, E, nullptr);
#endif
    }
    GRID_BAR();

#if REP_MEM > 1
    pool_phase(QKV, p.l1_scale, AB);
#endif
    pool_phase(QKV, p.l1_scale, AB);
    GRID_BAR();

    {
        pg8::Gemm g{AB, WtOut1, MTOK, 2048, 2048, 2048, 2048}; pg8::StaticOrder S; S.init(MTOK, 2048, G, bid);
        EpiGateB E{H, mod + 3 * 6144 + 4096};
        pg8::gemm_phase<EpiGateB, pg8::StaticOrder, false>(lds, g, S, E, nullptr);
    }
    GRID_BAR();

#ifdef REP_SYNC
    for (int rep = 0; rep < REP_SYNC; ++rep) GRID_BAR();
#endif
    final_norm_phase(p.out, H, p.final_norm);
}

extern "C" void kernel_launch(void* const* d_in, const int* in_sizes, int n_in, void* d_out, int out_size, void* d_ws, size_t ws_size, hipStream_t stream) {
    static int grid_blocks = 0;
    if (!grid_blocks) {
        int dev = 0, cus = 0, per_cu = 0;
        (void)hipGetDevice(&dev);
        (void)hipDeviceGetAttribute(&cus, hipDeviceAttributeMultiprocessorCount, dev);
        (void)hipFuncSetAttribute((const void*)fwd_mega, hipFuncAttributeMaxDynamicSharedMemorySize, LDS_BYTES);
        (void)hipOccupancyMaxActiveBlocksPerMultiprocessor(&per_cu, (const void*)fwd_mega, 512, LDS_BYTES);
        if (per_cu < 1) per_cu = 1;
        grid_blocks = cus * per_cu;
        if (ws_size < WS_END) fprintf(stderr, "kernel_launch: workspace too small (%zu < %zu)\n", ws_size, (size_t)WS_END);
    }
    Params p{};
    p.x = (const float*)d_in[0]; p.c = (const float*)d_in[1]; p.ctx = (const float*)d_in[2]; p.c_ctx = (const float*)d_in[3];
    p.l0_norm = (const float*)d_in[4]; p.l0_w_mod = (const float*)d_in[5]; p.l0_b_mod = (const float*)d_in[6]; p.l0_w_in = (const float*)d_in[7];
    p.l0_sink = (const float*)d_in[8]; p.l0_w_f = (const float*)d_in[9]; p.l0_w_out = (const float*)d_in[10];
    p.l1_norm = (const float*)d_in[11]; p.l1_w_mod = (const float*)d_in[12]; p.l1_b_mod = (const float*)d_in[13]; p.l1_w_in = (const float*)d_in[14];
    p.l1_w_grp = (const float*)d_in[15]; p.l1_scale = (const float*)d_in[16]; p.l1_w_out = (const float*)d_in[17]; p.final_norm = (const float*)d_in[18];
    p.out = (float*)d_out; p.ws = (unsigned char*)d_ws;
#ifndef USE_CG_SYNC
    (void)hipMemsetAsync((char*)d_ws + WS_XBAR, 0, 16384, stream);
#endif
    void* args[] = {&p};
    hipError_t e = hipLaunchCooperativeKernel((void*)fwd_mega, dim3(grid_blocks), dim3(512), args, LDS_BYTES, stream);
    if (e != hipSuccess) fprintf(stderr, "cooperative launch failed: %s (grid %d)\n", hipGetErrorString(e), grid_blocks);
}
```

```cpp
#include <hip/hip_runtime.h>
#include <hip/hip_cooperative_groups.h>
#include <cstdio>
namespace cg = cooperative_groups;

namespace pg8 {
#define PG8_LAS __attribute__((address_space(3)))
typedef unsigned short bf16_t;
typedef short bf16x8 __attribute__((ext_vector_type(8)));
typedef float f32x4 __attribute__((ext_vector_type(4)));
typedef unsigned u32x4 __attribute__((ext_vector_type(4)));
constexpr int BM = 256, BK = 64, HALF = 128, HTB = HALF * BK * 2  , STAGE_BYTES = 8 * HTB, NXCD = 8, WGM = 8;

__host__ __device__ __forceinline__ int lds_byte(int r, int c) { const int st = (r >> 4) * 2 + (c >> 5), rr = r & 15, cc = c & 31, ob = rr * 64 + cc * 2; return st * 1024 + (ob ^ (((ob >> 9) & 1) << 5)); }
__host__ __device__ __forceinline__ void stage_rc(int b, int& R, int& C) { const int st = b / 1024, sb = b % 1024, swz = sb ^ (((sb >> 9) & 1) << 5); R = (st >> 1) * 16 + swz / 64; C = (st & 1) * 32 + (swz % 64) / 2; }
__host__ __device__ __forceinline__ int perm32(int rho) { const int n = rho >> 4, i = rho & 15; return 8 * (i >> 2) + 4 * n + (i & 3); }

struct Unit { int pm, pn; };
struct Gemm { const bf16_t* A; const bf16_t* Bt; int M, N, K, lda, ldb; };

struct StaticOrder {
    int nM, nN, nwg, G, c;
    __host__ __device__ void init(int M, int N, int G_, int c_) { nM = M / BM; nN = N / BM; nwg = nM * nN; G = G_; c = c_; }
    __host__ __device__ bool next(int i, Unit& u) const {
        const long L = (long)i * G + c; if (L >= nwg) return false;
        int wgid = (int)L; { const int q = nwg / NXCD, r = nwg % NXCD, xcd = wgid % NXCD, off = wgid / NXCD; wgid = (xcd < r ? xcd * (q + 1) : r * (q + 1) + (xcd - r) * q) + off; }
        const int nig = WGM * nN, gid = wgid / nig, fm = gid * WGM, gsz = (nM - fm) < WGM ? (nM - fm) : WGM;
        u.pm = fm + ((wgid % nig) % gsz); u.pn = (wgid % nig) / gsz; return true;
    }
    __device__ __forceinline__ void a_ready(const Unit&) const {}
    __device__ __forceinline__ void done(const Unit&) const {}
};
__device__ __forceinline__ unsigned cvt_pk_bf16(float lo, float hi) { unsigned r; asm("v_cvt_pk_bf16_f32 %0, %1, %2" : "=v"(r) : "v"(lo), "v"(hi)); return r; }
template <class Epi, class Sched, bool STAMP = false>
__device__ __forceinline__ void gemm_phase(PG8_LAS unsigned char* lds, const Gemm g, const Sched& S, const Epi& E, unsigned long long* stamps) {
    const int tid = threadIdx.x, wid = __builtin_amdgcn_readfirstlane(tid >> 6), lane = tid & 63, wr = wid >> 2, wc = wid & 3, fr = lane & 15, fq = lane >> 4;
    const int K = g.K, nt = K / BK;
    int ts_lo = 0, ts_hi = 0, nts = 0; const unsigned long long rt_entry = STAMP ? (unsigned long long)wall_clock64() : 0ull;
#define PG8_STAMP() do { if (STAMP && wid == 0 && nts < 64) { const unsigned long long _c = (unsigned long long)clock64(); \
        ts_lo = (lane == nts) ? (int)(unsigned)_c : ts_lo; ts_hi = (lane == nts) ? (int)(unsigned)(_c >> 32) : ts_hi; ++nts; } } while (0)
    PG8_STAMP();
    unsigned voffA[2], voffB[2];
#pragma unroll
    for (int i = 0; i < 2; ++i) { int R, C; stage_rc(tid * 16 + i * 8192, R, C); const int Rb = Epi::PERM ? ((R & ~31) + perm32(R & 31)) : R;
        voffA[i] = (unsigned)(R * g.lda + C) * 2u; voffB[i] = (unsigned)(Rb * g.ldb + C) * 2u; }
    const size_t kstep = (size_t)(BK * 2);
    const size_t hstepA = (size_t)HALF * g.lda * 2, hstepB = (size_t)HALF * g.ldb * 2;
    const size_t tstepA = 2 * hstepA, tstepB = 2 * hstepB;
    const unsigned ldsw = (unsigned)wid * 1024u;
    const int aoff = lds_byte(wr * 64 + fr, fq * 8), boff = lds_byte(wc * 32 + fr, fq * 8);
#define PG8_SA(b, h) (((b) * 2 + (h)) * HTB)
#define PG8_SB(b, h) ((4 + (b) * 2 + (h)) * HTB)
#define PG8_STAGE(bufoff, gbase, voff) do { _Pragma("unroll") for (int _i = 0; _i < 2; ++_i) \
        __builtin_amdgcn_global_load_lds((const unsigned*)((const char*)(gbase) + (voff)[_i]), (PG8_LAS unsigned*)(lds + (bufoff) + ldsw + _i * 8192), 16, 0, 0); } while (0)
#define PG8_LDA(dst, b, h) do { _Pragma("unroll") for (int m = 0; m < 4; ++m) _Pragma("unroll") for (int k = 0; k < 2; ++k) dst[m][k] = *(const PG8_LAS bf16x8*)(lds + PG8_SA(b, h) + aoff + m * 2048 + k * 1024); } while (0)
#define PG8_LDB(dst, b, h) do { _Pragma("unroll") for (int n = 0; n < 2; ++n) _Pragma("unroll") for (int k = 0; k < 2; ++k) dst[n][k] = *(const PG8_LAS bf16x8*)(lds + PG8_SB(b, h) + boff + n * 2048 + k * 1024); } while (0)
#define PG8_MMA(ai, bj, At, Bt) do { __builtin_amdgcn_s_setprio(1); _Pragma("unroll") for (int m = 0; m < 4; ++m) _Pragma("unroll") for (int n = 0; n < 2; ++n) _Pragma("unroll") for (int k = 0; k < 2; ++k) \
        acc[ai][bj][m][n] = __builtin_amdgcn_mfma_f32_16x16x32_bf16(Bt[n][k], At[m][k], acc[ai][bj][m][n], 0, 0, 0); __builtin_amdgcn_s_setprio(0); } while (0)
#define PG8_WAIT_V(n) asm volatile("s_waitcnt vmcnt(" #n ")" ::: "memory")
#define PG8_WAIT_L(n) asm volatile("s_waitcnt lgkmcnt(" #n ")" ::: "memory")
#define PG8_BAR __builtin_amdgcn_s_barrier()
#define PG8_SCHED __builtin_amdgcn_sched_barrier(0)
    Unit cur, nxt; int ui = 0;
    if (!S.next(0, cur)) return;
    f32x4 acc[2][2][4][2];
#pragma unroll
    for (int a = 0; a < 2; ++a)
#pragma unroll
        for (int b = 0; b < 2; ++b)
#pragma unroll
            for (int m = 0; m < 4; ++m)
#pragma unroll
                for (int n = 0; n < 2; ++n) acc[a][b][m][n] = (f32x4){0.f, 0.f, 0.f, 0.f};
    bf16x8 At[4][2], B0[2][2], B1[2][2];
    const char* cA = (const char*)g.A + (size_t)cur.pm * tstepA; const char* cB = (const char*)g.Bt + (size_t)cur.pn * tstepB;
    S.a_ready(cur);
    PG8_STAGE(PG8_SB(0, 0), cB, voffB); PG8_STAGE(PG8_SA(0, 0), cA, voffA); PG8_STAGE(PG8_SB(0, 1), cB + hstepB, voffB); PG8_STAGE(PG8_SA(0, 1), cA + hstepA, voffA);
    if (wr == 1) PG8_BAR;
    PG8_WAIT_V(4); PG8_BAR;
    PG8_STAGE(PG8_SB(1, 0), cB + kstep, voffB); PG8_STAGE(PG8_SA(1, 0), cA + kstep, voffA); PG8_STAGE(PG8_SB(1, 1), cB + hstepB + kstep, voffB);
    PG8_WAIT_V(6); PG8_BAR;
    PG8_STAMP();
    for (;;) {
        const bool has_next = S.next(ui + 1, nxt);
        const char* nA = has_next ? (const char*)g.A + (size_t)nxt.pm * tstepA : cA; const char* nB = has_next ? (const char*)g.Bt + (size_t)nxt.pn * tstepB : cB;
        for (int t = 0; t < nt; t += 2) {
            const bool last = (t == nt - 2);
            const char* a1 = cA + (size_t)(t + 1) * kstep;
            const char* a2 = last ? nA : cA + (size_t)(t + 2) * kstep; const char* b2 = last ? nB : cB + (size_t)(t + 2) * kstep;
            const char* a3 = a2 + kstep; const char* b3 = b2 + kstep;
            if (last && has_next) S.a_ready(nxt);
            PG8_LDB(B0, 0, 0); PG8_SCHED; PG8_LDA(At, 0, 0); PG8_STAGE(PG8_SA(1, 1), a1 + hstepA, voffA);
            PG8_WAIT_L(8); PG8_BAR; PG8_WAIT_L(0); PG8_MMA(0, 0, At, B0); PG8_BAR; PG8_SCHED;
            PG8_LDB(B1, 0, 1); PG8_STAGE(PG8_SB(0, 0), b2, voffB);
            PG8_BAR; PG8_WAIT_L(0); PG8_MMA(0, 1, At, B1); PG8_BAR;
            PG8_LDA(At, 0, 1); PG8_STAGE(PG8_SA(0, 0), a2, voffA);
            PG8_BAR; PG8_WAIT_L(0); PG8_MMA(1, 0, At, B0); PG8_BAR; PG8_SCHED;
            PG8_STAGE(PG8_SB(0, 1), b2 + hstepB, voffB);
            PG8_WAIT_V(6); PG8_BAR; PG8_MMA(1, 1, At, B1); PG8_BAR;
            PG8_LDB(B0, 1, 0); PG8_SCHED; PG8_LDA(At, 1, 0); PG8_STAGE(PG8_SA(0, 1), a2 + hstepA, voffA);
            PG8_WAIT_L(8); PG8_BAR; PG8_WAIT_L(0); PG8_MMA(0, 0, At, B0); PG8_BAR; PG8_SCHED;
            PG8_LDB(B1, 1, 1); PG8_STAGE(PG8_SB(1, 0), b3, voffB);
            PG8_BAR; PG8_WAIT_L(0); PG8_MMA(0, 1, At, B1); PG8_BAR;
            PG8_LDA(At, 1, 1); PG8_STAGE(PG8_SA(1, 0), a3, voffA);
            PG8_BAR; PG8_WAIT_L(0); PG8_MMA(1, 0, At, B0); PG8_BAR; PG8_SCHED;
            PG8_STAGE(PG8_SB(1, 1), b3 + hstepB, voffB);
            PG8_WAIT_V(6); PG8_BAR; PG8_MMA(1, 1, At, B1); PG8_BAR;
        }
        PG8_STAMP();
        if constexpr (!Epi::AFTER_DRAIN) { E(acc, cur, wr, wc, fr, fq); S.done(cur); }
        PG8_STAMP();
        if (!has_next) break;
#pragma unroll
        for (int a = 0; a < 2; ++a)
#pragma unroll
            for (int b = 0; b < 2; ++b)
#pragma unroll
                for (int m = 0; m < 4; ++m)
#pragma unroll
                    for (int n = 0; n < 2; ++n) acc[a][b][m][n] = (f32x4){0.f, 0.f, 0.f, 0.f};
        cur = nxt; cA = nA; cB = nB; ++ui;
    }
    PG8_WAIT_V(0);
    if (wr == 0) PG8_BAR;
    PG8_BAR;
    if constexpr (Epi::AFTER_DRAIN) { E.fused(acc, cur, wr, wc, fr, fq, lds, wid, lane); S.done(cur); }
    PG8_STAMP();
    if (STAMP && wid == 0) { stamps[lane] = lane < nts ? (((unsigned long long)(unsigned)ts_hi << 32) | (unsigned)ts_lo) : 0ull;
        if (lane == 62) stamps[62] = rt_entry; if (lane == 63) stamps[63] = (unsigned long long)wall_clock64(); }
#undef PG8_STAMP
#undef PG8_SA
#undef PG8_SB
#undef PG8_STAGE
#undef PG8_LDA
#undef PG8_LDB
#undef PG8_MMA
#undef PG8_WAIT_V
#undef PG8_WAIT_L
#undef PG8_BAR
#undef PG8_SCHED
}
}

#define LAS __attribute__((address_space(3)))
using pg8::bf16_t; using pg8::bf16x8; using pg8::f32x4; using pg8::u32x4; using pg8::cvt_pk_bf16;
typedef short s16x4 __attribute__((ext_vector_type(4)));
typedef unsigned u32x2 __attribute__((ext_vector_type(2)));
typedef float f32x2 __attribute__((ext_vector_type(2)));

constexpr int DM = 2048, SEQ = 16384, MTOK = 32768;
constexpr int LDQ = 5120;
constexpr int OFF_K = 1536, OFF_V = 2048, OFF_F = 2560, OFF_Z = 3072;
constexpr float LOG2E = 1.4426950408889634f;
constexpr float QSCALE = 0.08838834764831845f * 1.4426950408889634f;
constexpr int LDS_BYTES = 143360;
#ifndef REP_ATT
#define REP_ATT 1
#endif
#ifndef REP_FA
#define REP_FA 1
#endif
#ifndef REP_FB
#define REP_FB 1
#endif
#ifndef REP_POOL
#define REP_POOL 1
#endif
#ifndef REP_P0
#define REP_P0 1
#endif
#ifndef REP_G0
#define REP_G0 1
#endif
#ifndef REP_P4
#define REP_P4 1
#endif
#ifndef REP_G2
#define REP_G2 1
#endif
#ifndef REP_MEM
#define REP_MEM 1
#endif

constexpr size_t WS_BAR = 0;
constexpr size_t WS_MOD = 256;
constexpr size_t WS_ROPE = WS_MOD + 147456;
constexpr size_t WS_DC = WS_ROPE + 81920;
constexpr size_t WS_EC = WS_DC + 65536;
constexpr size_t WS_MGT = WS_EC + 131072;
constexpr size_t WS_WTIN0 = WS_MGT + 262144;
constexpr size_t WS_WTOUT0 = WS_WTIN0 + 20971520;
constexpr size_t WS_WTIN1 = WS_WTOUT0 + 8388608;
constexpr size_t WS_WTOUT1 = WS_WTIN1 + 16777216;
constexpr size_t WS_WBF1 = WS_WTOUT1 + 8388608;
constexpr size_t WS_WGRPT = WS_WBF1 + 8388608;
constexpr size_t WS_H = WS_WGRPT + 2097152;
constexpr size_t WS_HC = WS_H + 134217728;
constexpr size_t WS_QKV = WS_HC + 2097152;
constexpr size_t WS_KCVC = WS_QKV + 335544320;
constexpr size_t WS_Y = WS_KCVC + 1048576;
constexpr size_t WS_A = WS_Y + 67108864;
constexpr size_t WS_RSS = WS_A + 134217728;
constexpr size_t WS_BIAS1 = WS_RSS + 131072;
constexpr size_t WS_XBAR = WS_BIAS1 + 32768;
constexpr size_t WS_END = WS_XBAR + 16384;

struct Params {
    const float *x, *c, *ctx, *c_ctx;
    const float *l0_norm, *l0_w_mod, *l0_b_mod, *l0_w_in, *l0_sink, *l0_w_f, *l0_w_out;
    const float *l1_norm, *l1_w_mod, *l1_b_mod, *l1_w_in, *l1_w_grp, *l1_scale, *l1_w_out, *final_norm;
    float* out; unsigned char* ws;
};

__device__ __forceinline__ float bflo(unsigned u) { return __uint_as_float(u << 16); }
__device__ __forceinline__ float bfhi(unsigned u) { return __uint_as_float(u & 0xffff0000u); }
__device__ __forceinline__ unsigned short f2bf(float f) { return (unsigned short)(cvt_pk_bf16(f, f) & 0xffffu); }
__device__ __forceinline__ float silu(float v) { return v * __builtin_amdgcn_rcpf(1.0f + __expf(-v)); }
__device__ __forceinline__ f32x4 mfma16(bf16x8 a, bf16x8 b, f32x4 c) { return __builtin_amdgcn_mfma_f32_16x16x32_bf16(a, b, c, 0, 0, 0); }
__device__ __forceinline__ bf16x8 tr2(LAS unsigned char* p0, LAS unsigned char* p1) {
    const s16x4 a = __builtin_amdgcn_ds_read_tr16_b64_v4i16((LAS s16x4*)p0);
    const s16x4 b = __builtin_amdgcn_ds_read_tr16_b64_v4i16((LAS s16x4*)p1);
    return __builtin_shufflevector(a, b, 0, 1, 2, 3, 4, 5, 6, 7);
}
__device__ __forceinline__ bf16x8 pack8(f32x4 a, f32x4 b) {
    u32x4 w; w.x = cvt_pk_bf16(a[0], a[1]); w.y = cvt_pk_bf16(a[2], a[3]); w.z = cvt_pk_bf16(b[0], b[1]); w.w = cvt_pk_bf16(b[2], b[3]);
    return __builtin_bit_cast(bf16x8, w);
}
__device__ __forceinline__ u32x2 pack4(f32x4 a) { u32x2 w; w.x = cvt_pk_bf16(a[0], a[1]); w.y = cvt_pk_bf16(a[2], a[3]); return w; }
__device__ __forceinline__ f32x4 unpack4(u32x2 w) { return (f32x4){bflo(w.x), bfhi(w.x), bflo(w.y), bfhi(w.y)}; }
__device__ __forceinline__ f32x4 silu4(f32x4 z) { return (f32x4){silu(z[0]), silu(z[1]), silu(z[2]), silu(z[3])}; }

template <int MODE> struct EpiB {
    static constexpr bool PERM = true, AFTER_DRAIN = false;
    bf16_t* O; int ldc; const f32x2* rope;
    __device__ __forceinline__ void operator()(const f32x4 (&acc)[2][2][4][2], const pg8::Unit& u, int wr, int wc, int fr, int fq) const {
        const int row0 = u.pm * 256 + wr * 64 + fr, col0 = u.pn * 256 + wc * 32 + 8 * fq;
#pragma unroll
        for (int ai = 0; ai < 2; ++ai)
#pragma unroll
            for (int m = 0; m < 4; ++m) {
                const int row = row0 + ai * 128 + m * 16;
                bf16_t* rowp = O + (size_t)row * ldc + col0;
#pragma unroll
                for (int bj = 0; bj < 2; ++bj) {
                    f32x4 v0 = acc[ai][bj][m][0], v1 = acc[ai][bj][m][1];
                    if (MODE == 1 && u.pn < 8) {
                        const int s = row & (SEQ - 1);
                        const int t0 = ((col0 + bj * 128) & 127) >> 1;
                        const f32x2* tp = rope + (t0 < 32 ? ((s >> 6) * 32 + t0) : ((256 + (s & 63)) * 32 + (t0 - 32)));
                        const f32x4 c01 = *(const f32x4*)tp, c23 = *(const f32x4*)(tp + 2);
                        const float sc = (u.pn < 6) ? QSCALE : 1.0f;
                        f32x4 r0, r1;
                        r0[0] = (v0[0] * c01[0] - v0[1] * c01[1]) * sc; r0[1] = (v0[1] * c01[0] + v0[0] * c01[1]) * sc;
                        r0[2] = (v0[2] * c01[2] - v0[3] * c01[3]) * sc; r0[3] = (v0[3] * c01[2] + v0[2] * c01[3]) * sc;
                        r1[0] = (v1[0] * c23[0] - v1[1] * c23[1]) * sc; r1[1] = (v1[1] * c23[0] + v1[0] * c23[1]) * sc;
                        r1[2] = (v1[2] * c23[2] - v1[3] * c23[3]) * sc; r1[3] = (v1[3] * c23[2] + v1[2] * c23[3]) * sc;
                        v0 = r0; v1 = r1;
                    }
                    u32x4 w; w.x = cvt_pk_bf16(v0[0], v0[1]); w.y = cvt_pk_bf16(v0[2], v0[3]); w.z = cvt_pk_bf16(v1[0], v1[1]); w.w = cvt_pk_bf16(v1[2], v1[3]);
                    *(u32x4*)(rowp + bj * 128) = w;
                }
            }
    }
};
struct EpiRes {
    static constexpr bool PERM = false, AFTER_DRAIN = false;
    const float* base; float* out; const float* gate;
    __device__ __forceinline__ void operator()(const f32x4 (&acc)[2][2][4][2], const pg8::Unit& u, int wr, int wc, int fr, int fq) const {
        const int row0 = u.pm * 256 + wr * 64 + fr, col0 = u.pn * 256 + wc * 32 + 4 * fq;
        const float* gp = gate + (size_t)(u.pm >> 6) * 6144 + col0;
        f32x4 gv[2][2];
#pragma unroll
        for (int bj = 0; bj < 2; ++bj)
#pragma unroll
            for (int n = 0; n < 2; ++n) gv[bj][n] = *(const f32x4*)(gp + bj * 128 + n * 16);
#pragma unroll
        for (int ai = 0; ai < 2; ++ai)
#pragma unroll
            for (int m = 0; m < 4; ++m) {
                const size_t off = (size_t)(row0 + ai * 128 + m * 16) * DM + col0;
#pragma unroll
                for (int bj = 0; bj < 2; ++bj)
#pragma unroll
                    for (int n = 0; n < 2; ++n) {
                        const f32x4 bs = *(const f32x4*)(base + off + bj * 128 + n * 16);
                        *(f32x4*)(out + off + bj * 128 + n * 16) = bs + gv[bj][n] * acc[ai][bj][m][n];
                    }
                asm volatile("" ::: "memory");
            }
    }
};
struct EpiResNext {
    static constexpr bool PERM = true, AFTER_DRAIN = false;
    const float* base; float* out; const float* gate; bf16_t* hu; const float* gnext; const float* scnext; float* rss;
    __device__ __forceinline__ void operator()(const f32x4 (&acc)[2][2][4][2], const pg8::Unit& u, int wr, int wc, int fr, int fq) const {
        const int row0 = u.pm * 256 + wr * 64 + fr, col0 = u.pn * 256 + wc * 32 + 8 * fq, b = u.pm >> 6;
        float ss[8];
#pragma unroll
        for (int i = 0; i < 8; ++i) ss[i] = 0.f;
#pragma unroll
        for (int bj = 0; bj < 2; ++bj) {
            const int col = col0 + bj * 128;
            const f32x4 gv0 = *(const f32x4*)(gate + (size_t)b * 6144 + col), gv1 = *(const f32x4*)(gate + (size_t)b * 6144 + col + 4);
#pragma unroll
            for (int ai = 0; ai < 2; ++ai)
#pragma unroll
                for (int m = 0; m < 4; ++m) {
                    const size_t off = (size_t)(row0 + ai * 128 + m * 16) * DM + col;
                    const f32x4 x0 = *(const f32x4*)(base + off) + gv0 * acc[ai][bj][m][0];
                    const f32x4 x1 = *(const f32x4*)(base + off + 4) + gv1 * acc[ai][bj][m][1];
                    *(f32x4*)(out + off) = x0; *(f32x4*)(out + off + 4) = x1;
                    ss[ai * 4 + m] += ((x0[0] * x0[0] + x0[1] * x0[1]) + (x0[2] * x0[2] + x0[3] * x0[3])) + ((x1[0] * x1[0] + x1[1] * x1[1]) + (x1[2] * x1[2] + x1[3] * x1[3]));
                    const f32x4 cf0 = *(const f32x4*)(gnext + col) * (1.0f + *(const f32x4*)(scnext + (size_t)b * 6144 + col));
                    const f32x4 cf1 = *(const f32x4*)(gnext + col + 4) * (1.0f + *(const f32x4*)(scnext + (size_t)b * 6144 + col + 4));
                    *(bf16x8*)(hu + off) = pack8(x0 * cf0, x1 * cf1);
                    if (m & 1) asm volatile("" ::: "memory");
                }
        }
#pragma unroll
        for (int i = 0; i < 8; ++i) {
            float v = ss[i]; v += __shfl_xor(v, 16); v += __shfl_xor(v, 32);
            if (fq == 0) (void)__hip_atomic_fetch_add(rss + row0 + (i >> 2) * 128 + (i & 3) * 16, v, __ATOMIC_RELAXED, __HIP_MEMORY_SCOPE_AGENT);
        }
    }
};
struct EpiBNorm {
    static constexpr bool PERM = true, AFTER_DRAIN = false;
    bf16_t* O; int ldc; const float* rss; const float* bias;
    __device__ __forceinline__ void operator()(const f32x4 (&acc)[2][2][4][2], const pg8::Unit& u, int wr, int wc, int fr, int fq) const {
        const int row0 = u.pm * 256 + wr * 64 + fr, col0 = u.pn * 256 + wc * 32 + 8 * fq;
        const float* bp = bias + (size_t)(u.pm >> 6) * ldc + col0;
        f32x4 bv[2][2];
#pragma unroll
        for (int bj = 0; bj < 2; ++bj)
#pragma unroll
            for (int n = 0; n < 2; ++n) bv[bj][n] = *(const f32x4*)(bp + bj * 128 + 4 * n);
#pragma unroll
        for (int ai = 0; ai < 2; ++ai)
#pragma unroll
            for (int m = 0; m < 4; ++m) {
                const int row = row0 + ai * 128 + m * 16;
                const float rs = rsqrtf(rss[row] * (1.0f / 2048.0f) + 1e-6f);
                bf16_t* rowp = O + (size_t)row * ldc + col0;
#pragma unroll
                for (int bj = 0; bj < 2; ++bj) {
                    const f32x4 v0 = acc[ai][bj][m][0] * rs + bv[bj][0], v1 = acc[ai][bj][m][1] * rs + bv[bj][1];
                    u32x4 w; w.x = cvt_pk_bf16(v0[0], v0[1]); w.y = cvt_pk_bf16(v0[2], v0[3]); w.z = cvt_pk_bf16(v1[0], v1[1]); w.w = cvt_pk_bf16(v1[2], v1[3]);
                    *(u32x4*)(rowp + bj * 128) = w;
                }
            }
    }
};
struct EpiGateB {
    static constexpr bool PERM = true, AFTER_DRAIN = false;
    bf16_t* O; const float* gate;
    __device__ __forceinline__ void operator()(const f32x4 (&acc)[2][2][4][2], const pg8::Unit& u, int wr, int wc, int fr, int fq) const {
        const int row0 = u.pm * 256 + wr * 64 + fr, col0 = u.pn * 256 + wc * 32 + 8 * fq;
        const float* gp = gate + (size_t)(u.pm >> 6) * 6144 + col0;
        f32x4 gv[2][2];
#pragma unroll
        for (int bj = 0; bj < 2; ++bj)
#pragma unroll
            for (int n = 0; n < 2; ++n) gv[bj][n] = *(const f32x4*)(gp + bj * 128 + 4 * n);
#pragma unroll
        for (int ai = 0; ai < 2; ++ai)
#pragma unroll
            for (int m = 0; m < 4; ++m) {
                bf16_t* rowp = O + (size_t)(row0 + ai * 128 + m * 16) * DM + col0;
#pragma unroll
                for (int bj = 0; bj < 2; ++bj) *(bf16x8*)(rowp + bj * 128) = pack8(acc[ai][bj][m][0] * gv[bj][0], acc[ai][bj][m][1] * gv[bj][1]);
            }
    }
};
struct OneUnit {
    int has; pg8::Unit u;
    __device__ bool next(int i, pg8::Unit& o) const { if (i > 0 || !has) return false; o = u; return true; }
    __device__ __forceinline__ void a_ready(const pg8::Unit&) const {}
    __device__ __forceinline__ void done(const pg8::Unit&) const {}
};

__device__ __forceinline__ void transpose_tile(const float* W, int ldw, int k0, int n0, bf16_t* Wt, int ldt, int nd0, bool ropeperm, LAS bf16_t* tt) {
    const int tid = threadIdx.x;
#pragma unroll
    for (int it = 0; it < 8; ++it) {
        const int idx = it * 512 + tid, kk = idx >> 5, n4 = (idx & 31) * 4;
        const f32x4 v = *(const f32x4*)(W + (size_t)(k0 + kk) * ldw + n0 + n4);
#pragma unroll
        for (int e = 0; e < 4; ++e) {
            int nn = n4 + e;
            if (ropeperm) { const int hs = (nn >> 5) & 1, t = (nn & 31) + ((nn >> 6) << 5); nn = 2 * t + hs; }
            tt[nn * 132 + kk] = f2bf(v[e]);
        }
    }
    __syncthreads();
#pragma unroll
    for (int it = 0; it < 8; ++it) {
        const int idx = it * 512 + tid, nn = idx >> 5, ch = idx & 31;
        const u32x2 w = *(const LAS u32x2*)(tt + nn * 132 + ch * 4);
        *(u32x2*)(Wt + (size_t)(nd0 + nn) * ldt + k0 + ch * 4) = w;
    }
    __syncthreads();
}

__device__ void phase0(const Params& p, LAS unsigned char* lds) {
    const int tid = threadIdx.x;
    LAS float* sc = (LAS float*)lds;
    LAS float* red = (LAS float*)(lds + 24576);
    LAS float* trig = (LAS float*)(lds + 49152);
    LAS bf16_t* tt = (LAS bf16_t*)(lds + 53248);
    unsigned char* ws = p.ws;
    for (int i = tid; i < 3 * DM; i += 512) { const int r = i >> 11, k = i & 2047; const float v = r < 2 ? p.c[r * DM + k] : p.c_ctx[k]; sc[i] = silu(v); }
    if (tid < 128) { float s, c; sincospif((float)tid * (1.0f / 64.0f), &s, &c); trig[tid] = c; trig[128 + tid] = s; }
    __syncthreads();
    constexpr int J0 = 192, J1 = J0 + 640, J2 = J1 + 256, J3 = J2 + 256, J4 = J3 + 256, J5 = J4 + 64, J6 = J5 + 256, J7 = J6 + 20, J8 = J7 + 64, J9 = J8 + 128, J10 = J9 + 256, J11 = J10 + 64;
    for (int job = blockIdx.x; job < J11; job += gridDim.x) {
        if (job < J0) {
            const int L = job / 96, cc = job % 96;
            const float* wm = L ? p.l1_w_mod : p.l0_w_mod; const float* bm = L ? p.l1_b_mod : p.l0_b_mod;
            const int sub = tid & 15, rg = tid >> 4, col = cc * 64 + sub * 4;
            f32x4 a0 = {0.f, 0.f, 0.f, 0.f}, a1 = a0, a2 = a0;
            const float* wp = wm + (size_t)(rg * 64) * 6144 + col;
#pragma unroll 8
            for (int i = 0; i < 64; ++i) {
                const f32x4 w = *(const f32x4*)(wp + (size_t)i * 6144);
                const int k = rg * 64 + i;
                a0 += sc[k] * w; a1 += sc[2048 + k] * w; a2 += sc[4096 + k] * w;
            }
#pragma unroll
            for (int e = 0; e < 4; ++e) { red[(rg * 3 + 0) * 64 + sub * 4 + e] = a0[e]; red[(rg * 3 + 1) * 64 + sub * 4 + e] = a1[e]; red[(rg * 3 + 2) * 64 + sub * 4 + e] = a2[e]; }
            __syncthreads();
            if (tid < 192) {
                const int r = tid >> 6, cl = tid & 63; float s = bm[cc * 64 + cl];
                for (int g = 0; g < 32; ++g) s += red[(g * 3 + r) * 64 + cl];
                ((float*)(ws + WS_MOD))[(size_t)(L * 3 + r) * 6144 + cc * 64 + cl] = s;
            }
            __syncthreads();
        } else if (job < J1) {
            const int j = job - J0, nt = j % 40, kt = j / 40;
            transpose_tile(p.l0_w_in, 5120, kt * 128, nt * 128, (bf16_t*)(ws + WS_WTIN0), 2048, nt * 128, nt < 16, tt);
        } else if (job < J2) {
            const int j = job - J1, nt = j & 15, kt = j >> 4;
            transpose_tile(p.l0_w_out, 2048, kt * 128, nt * 128, (bf16_t*)(ws + WS_WTOUT0), 2048, nt * 128, false, tt);
        } else if (job < J3) {
            const int j = job - J2, nt = j & 15, kt = j >> 4;
            transpose_tile(p.l1_w_in, 4096, kt * 128, 2048 + nt * 128, (bf16_t*)(ws + WS_WTIN1), 2048, 2048 + nt * 128, false, tt);
        } else if (job < J4) {
            const int j = job - J3, nt = j & 15, kt = j >> 4;
            transpose_tile(p.l1_w_out, 2048, kt * 128, nt * 128, (bf16_t*)(ws + WS_WTOUT1), 2048, nt * 128, false, tt);
        } else if (job < J5) {
            const int j = job - J4, g = j >> 4, nt = j & 3, kt = (j >> 2) & 3;
            transpose_tile(p.l1_w_grp + (size_t)g * 262144, 512, kt * 128, nt * 128, (bf16_t*)(ws + WS_WGRPT) + (size_t)g * 262144, 512, nt * 128, false, tt);
        } else if (job < J6) {
            const int j = job - J5;
#pragma unroll
            for (int q = 0; q < 4; ++q) {
                const int e = (q * 512 + tid) * 8, row = j * 8 + (e >> 11), col = e & 2047;
                const float* sp = p.l1_w_in + (size_t)row * 4096 + col;
                const f32x4 v0 = *(const f32x4*)sp, v1 = *(const f32x4*)(sp + 4);
                *(bf16x8*)((bf16_t*)(ws + WS_WBF1) + (size_t)row * 2048 + col) = pack8(v0, v1);
            }
        } else if (job < J7) {
            const int e = (job - J6) * 512 + tid, pos = e >> 5, t = e & 31;
            const float pv = (float)(pos < 256 ? pos : pos - 256);
            const float inv = exp2f(-(float)t * (13.287712379549449f / 32.0f));
            float xr = pv * inv * 0.3183098861837907f;
            xr = xr - 2.0f * rintf(xr * 0.5f);
            float s, c; sincospif(xr, &s, &c);
            ((f32x2*)(ws + WS_ROPE))[e] = (f32x2){c, s};
        } else if (job < J8) {
            const int e = (job - J7) * 512 + tid, row = e >> 7, n1 = e & 127, kind = row >> 7, k1 = row & 127, ix = (k1 * n1) & 127;
            ((bf16_t*)(ws + WS_DC))[e] = f2bf(kind ? -trig[128 + ix] : trig[ix]);
        } else if (job < J9) {
            const int e = (job - J8) * 512 + tid, row = e >> 8, col = e & 255, kp = row >> 7, k2 = row & 127, kd = col >> 7, n2 = col & 127, ix = (k2 * n2) & 127;
            const float c = trig[ix], s = trig[128 + ix];
            ((bf16_t*)(ws + WS_EC))[e] = f2bf(kp == 0 ? (kd == 0 ? c : s) : (kd == 0 ? -s : c));
        } else if (job >= J10) {
            ((float*)(ws + WS_RSS))[(job - J10) * 512 + tid] = 0.f;
        } else {
            const int e = (job - J9) * 512 + tid, kc = e & 255, dp = (e >> 8) & 127, g = e >> 15, kind = kc >> 7;
            const int c = 32 * ((kc >> 5) & 3) + 16 * ((kc >> 2) & 1) + 4 * ((kc >> 3) & 3) + (kc & 3);
            const float* wf = p.l0_w_f + (size_t)g * 16384 + dp; float s = 0.f;
            for (int m = 0; m < 128; ++m) s += trig[kind * 128 + ((m * c) & 127)] * wf[m * 128];
            ((bf16_t*)(ws + WS_MGT))[(size_t)(g * 128 + dp) * 256 + kc] = f2bf(s * 6.905339660024878e-4f);
        }
    }
}

__device__ __forceinline__ void row_load8(const float* s, int lane, f32x4 (&v)[8]) {
#pragma unroll
    for (int j = 0; j < 8; ++j) v[j] = ((const f32x4*)s)[lane + 64 * j];
}
__device__ __forceinline__ float row_rstd(const f32x4 (&v)[8]) {
    float ss = 0.f;
#pragma unroll
    for (int j = 0; j < 8; ++j) ss += (v[j][0] * v[j][0] + v[j][1] * v[j][1]) + (v[j][2] * v[j][2] + v[j][3] * v[j][3]);
#pragma unroll
    for (int o = 32; o >= 1; o >>= 1) ss += __shfl_xor(ss, o);
    return rsqrtf(ss * (1.0f / 2048.0f) + 1e-6f);
}
struct NormArgs { const float* src; bf16_t* dst; const float* gamma; const float* modL; const float* ctx; bf16_t* hc; };
__device__ __forceinline__ const float* nm_src(const NormArgs& a, int r) { return r < MTOK ? a.src + (size_t)r * DM : a.ctx + (size_t)(r - MTOK) * DM; }
__device__ __forceinline__ void nm_finish(const NormArgs& a, int r, int lane, const f32x4 (&v)[8]) {
    bf16_t* d = r < MTOK ? a.dst + (size_t)r * DM : a.hc + (size_t)(r - MTOK) * DM;
    const float* mr = a.modL + (r < MTOK ? (r >> 14) : 2) * 6144;
    const float rs = row_rstd(v);
#pragma unroll
    for (int j = 0; j < 8; ++j) {
        const int c4 = lane + 64 * j;
        const f32x4 g = ((const f32x4*)a.gamma)[c4], sh = ((const f32x4*)mr)[c4], scl = ((const f32x4*)mr)[512 + c4];
        const f32x4 y = (v[j] * rs) * g * (1.0f + scl) + sh;
        *(u32x2*)(d + 4 * c4) = pack4(y);
    }
}
__device__ void norm_mod_phase(const float* src, bf16_t* dst, const float* gamma, const float* modL, const float* ctx, bf16_t* hc) {
    const int lane = threadIdx.x & 63, gw = blockIdx.x * 8 + (threadIdx.x >> 6), nw = gridDim.x * 8;
    const int total = ctx ? MTOK + 512 : MTOK;
    const NormArgs a{src, dst, gamma, modL, ctx, hc};
#ifdef REP_NORM
    for (int rep = 1; rep < REP_NORM; ++rep) { f32x4 vt[8]; for (int rr = gw; rr < total; rr += nw) { row_load8(nm_src(a, rr), lane, vt); nm_finish(a, rr, lane, vt); } }
#endif
    f32x4 va[8], vb[8];
    int r = gw;
    if (r < total) row_load8(nm_src(a, r), lane, va);
    while (r < total) {
        const int r2 = r + nw;
        if (r2 < total) row_load8(nm_src(a, r2), lane, vb);
        nm_finish(a, r, lane, va);
        if (r2 >= total) break;
        const int r3 = r2 + nw;
        if (r3 < total) row_load8(nm_src(a, r3), lane, va);
        nm_finish(a, r2, lane, vb);
        r = r3;
    }
}
__device__ __forceinline__ void fn_finish(float* io, const bf16_t* delta, const float* gamma, int r, int lane, f32x4 (&v)[8], const u32x2 (&dv)[8]) {
    f32x4* s = (f32x4*)(io + (size_t)r * DM);
#pragma unroll
    for (int j = 0; j < 8; ++j) v[j] += unpack4(dv[j]);
    const float rs = row_rstd(v);
#pragma unroll
    for (int j = 0; j < 8; ++j) s[lane + 64 * j] = (v[j] * rs) * ((const f32x4*)gamma)[lane + 64 * j];
}
__device__ __forceinline__ void drow_load8(const bf16_t* s, int lane, u32x2 (&v)[8]) {
#pragma unroll
    for (int j = 0; j < 8; ++j) v[j] = ((const u32x2*)s)[lane + 64 * j];
}
__device__ void final_norm_phase(float* io, const bf16_t* delta, const float* gamma) {
    const int lane = threadIdx.x & 63, gw = blockIdx.x * 8 + (threadIdx.x >> 6), nw = gridDim.x * 8;
    f32x4 va[8], vb[8]; u32x2 da[8], db[8];
    int r = gw;
    if (r < MTOK) { row_load8(io + (size_t)r * DM, lane, va); drow_load8(delta + (size_t)r * DM, lane, da); }
    while (r < MTOK) {
        const int r2 = r + nw;
        if (r2 < MTOK) { row_load8(io + (size_t)r2 * DM, lane, vb); drow_load8(delta + (size_t)r2 * DM, lane, db); }
        fn_finish(io, delta, gamma, r, lane, va, da);
        if (r2 >= MTOK) break;
        const int r3 = r2 + nw;
        if (r3 < MTOK) { row_load8(io + (size_t)r3 * DM, lane, va); drow_load8(delta + (size_t)r3 * DM, lane, da); }
        fn_finish(io, delta, gamma, r2, lane, vb, db);
        r = r3;
    }
}

__device__ void bias1_phase(const bf16_t* Wt, const float* mod1, float* bias) {
    const int lane = threadIdx.x & 63, gw = blockIdx.x * 8 + (threadIdx.x >> 6), nw = gridDim.x * 8;
    for (int col = gw; col < 4096; col += nw) {
        float s0 = 0.f, s1 = 0.f;
#pragma unroll
        for (int j = 0; j < 4; ++j) {
            const int k = (j * 64 + lane) * 8;
            const u32x4 wv = *(const u32x4*)(Wt + (size_t)col * 2048 + k);
            const float w8[8] = {bflo(wv.x), bfhi(wv.x), bflo(wv.y), bfhi(wv.y), bflo(wv.z), bfhi(wv.z), bflo(wv.w), bfhi(wv.w)};
            const f32x4 a0 = *(const f32x4*)(mod1 + k), a1 = *(const f32x4*)(mod1 + k + 4), b0 = *(const f32x4*)(mod1 + 6144 + k), b1 = *(const f32x4*)(mod1 + 6144 + k + 4);
            s0 += w8[0] * a0[0] + w8[1] * a0[1] + w8[2] * a0[2] + w8[3] * a0[3] + w8[4] * a1[0] + w8[5] * a1[1] + w8[6] * a1[2] + w8[7] * a1[3];
            s1 += w8[0] * b0[0] + w8[1] * b0[1] + w8[2] * b0[2] + w8[3] * b0[3] + w8[4] * b1[0] + w8[5] * b1[1] + w8[6] * b1[2] + w8[7] * b1[3];
        }
#pragma unroll
        for (int o = 32; o >= 1; o >>= 1) { s0 += __shfl_xor(s0, o); s1 += __shfl_xor(s1, o); }
        if (lane == 0) { bias[col] = s0; bias[4096 + col] = s1; }
    }
}

__device__ void fourier_a_phase(const bf16_t* qkv, const bf16_t* Dc, bf16_t* Y, LAS unsigned char* lds) {
    const int tid = threadIdx.x, lane = tid & 63, w = __builtin_amdgcn_readfirstlane(tid >> 6), g = lane >> 4, li = lane & 15, qq = li >> 2, pp = li & 3;
    const int k1 = 16 * w + li;
    bf16x8 db[2][4];
#pragma unroll
    for (int kd = 0; kd < 2; ++kd)
#pragma unroll
        for (int ks = 0; ks < 4; ++ks) db[kd][ks] = *(const bf16x8*)(Dc + (size_t)(kd * 128 + k1) * 128 + 32 * ks + 8 * g);
    const int fa_first = (gridDim.x > 64) ? (int)blockIdx.x - 8 : (int)blockIdx.x, fa_step = (gridDim.x > 64) ? (int)gridDim.x - 8 : (int)gridDim.x;
    for (int job0 = (fa_first < 0) ? 512 * REP_FA : fa_first; job0 < 512 * REP_FA; job0 += fa_step) {
        const int job = job0 & 511;
        const int chalf = job & 1, n2 = (job >> 1) & 127, b = job >> 8;
#pragma unroll
        for (int it = 0; it < 8; ++it) {
            const int idx = it * 512 + tid, r = idx >> 5, ch = idx & 31;
            const u32x4 v = *(const u32x4*)(qkv + ((size_t)b * SEQ + 128 * r + n2) * LDQ + OFF_F + 256 * chalf + ch * 8);
            *(LAS u32x4*)(lds + r * 528 + ch * 16) = v;
        }
        __syncthreads();
        float sn, cs; sincospif((float)((n2 * k1) & 16383) * (1.0f / 8192.0f), &sn, &cs);
        LAS unsigned char* fb = lds + (8 * g + qq) * 528 + 16 * pp;
        for (int c2 = 0; c2 < 2; ++c2) {
            f32x4 acc[8][2];
#pragma unroll
            for (int ct = 0; ct < 8; ++ct) { acc[ct][0] = (f32x4){0.f, 0.f, 0.f, 0.f}; acc[ct][1] = acc[ct][0]; }
#pragma unroll
            for (int ks = 0; ks < 4; ++ks)
#pragma unroll
                for (int ct = 0; ct < 8; ++ct) {
                    LAS unsigned char* a = fb + ks * 32 * 528 + (128 * c2 + 32 * (ct >> 1) + 4 * (ct & 1)) * 2;
                    const bf16x8 af = tr2(a, a + 4 * 528);
                    acc[ct][0] = mfma16(af, db[0][ks], acc[ct][0]);
                    acc[ct][1] = mfma16(af, db[1][ks], acc[ct][1]);
                }
            bf16_t* yr = Y + ((((size_t)b * 128 + k1) * 2 + 0) * 128 + n2) * 512 + 256 * chalf + 128 * c2 + 8 * g;
            bf16_t* yi = yr + (size_t)128 * 512;
#pragma unroll
            for (int k = 0; k < 4; ++k) {
                const f32x4 a0 = acc[2 * k][0], b0 = acc[2 * k][1], a1 = acc[2 * k + 1][0], b1 = acc[2 * k + 1][1];
                *(bf16x8*)(yr + 32 * k) = pack8(a0 * cs + b0 * sn, a1 * cs + b1 * sn);
                *(bf16x8*)(yi + 32 * k) = pack8(b0 * cs - a0 * sn, b1 * cs - a1 * sn);
            }
        }
        __syncthreads();
    }
}
__device__ void fourier_b_phase(const bf16_t* Y, const bf16_t* Ec, const bf16_t* MgT, const bf16_t* qkv, bf16_t* A0, LAS unsigned char* lds) {
    const int tid = threadIdx.x, lane = tid & 63, w = __builtin_amdgcn_readfirstlane(tid >> 6), g = lane >> 4, li = lane & 15, qq = li >> 2, pp = li & 3;
    const bool mlds = (gridDim.x & 3) == 0;
    LAS unsigned char* ms = lds + 69632;
    if (mlds) {
#pragma unroll
        for (int it = 0; it < 8; ++it) {
            const int idx = it * 512 + tid, r = idx >> 5, ch = idx & 31;
            *(LAS u32x4*)(ms + r * 528 + ch * 16) = *(const u32x4*)(MgT + (size_t)((blockIdx.x & 3) * 128 + r) * 256 + ch * 8);
        }
    }
    for (int job0 = blockIdx.x; job0 < 1024 * REP_FB; job0 += gridDim.x) {
        const int job = job0 & 1023;
        const int grp = job & 3, k1 = (job >> 2) & 127, b = job >> 9;
#pragma unroll
        for (int it = 0; it < 8; ++it) {
            const int idx = it * 512 + tid, r = idx >> 4, ch = idx & 15;
            const u32x4 v = *(const u32x4*)(Y + (((size_t)b * 128 + k1) * 256 + r) * 512 + 128 * grp + ch * 8);
            *(LAS u32x4*)(lds + r * 272 + ch * 16) = v;
        }
        __syncthreads();
        const int k2 = 16 * w + li;
        f32x4 acc[8][2];
#pragma unroll
        for (int ct = 0; ct < 8; ++ct) { acc[ct][0] = (f32x4){0.f, 0.f, 0.f, 0.f}; acc[ct][1] = acc[ct][0]; }
        LAS unsigned char* yb = lds + (8 * g + qq) * 272 + 8 * pp;
        const bf16_t* e0 = Ec + (size_t)k2 * 256 + 8 * g;
#pragma unroll 2
        for (int ks = 0; ks < 8; ++ks) {
            const bf16x8 eb0 = *(const bf16x8*)(e0 + 32 * ks), eb1 = *(const bf16x8*)(e0 + 128 * 256 + 32 * ks);
#pragma unroll
            for (int ct = 0; ct < 8; ++ct) {
                LAS unsigned char* a = yb + ks * 32 * 272 + 32 * ct;
                const bf16x8 af = tr2(a, a + 4 * 272);
                acc[ct][0] = mfma16(af, eb0, acc[ct][0]);
                acc[ct][1] = mfma16(af, eb1, acc[ct][1]);
            }
        }
        f32x4 o2[8];
#pragma unroll
        for (int dt = 0; dt < 8; ++dt) o2[dt] = (f32x4){0.f, 0.f, 0.f, 0.f};
        const bf16_t* mg = MgT + (size_t)(grp * 128 + 8 * (li >> 2) + (li & 3)) * 256 + 8 * g;
#pragma unroll
        for (int kp = 0; kp < 2; ++kp)
#pragma unroll
            for (int ks = 0; ks < 4; ++ks) {
                const bf16x8 bfr = pack8(acc[2 * ks][kp], acc[2 * ks + 1][kp]);
#pragma unroll
                for (int dt = 0; dt < 8; ++dt) {
                    const bf16x8 af = mlds ? *(const LAS bf16x8*)(ms + (8 * (li >> 2) + (li & 3) + 32 * (dt >> 1) + 4 * (dt & 1)) * 528 + (kp * 4 + ks) * 64 + 16 * g)
                                           : *(const bf16x8*)(mg + (size_t)(32 * (dt >> 1) + 4 * (dt & 1)) * 256 + (kp * 4 + ks) * 32);
                    o2[dt] = mfma16(af, bfr, o2[dt]);
                }
            }
        const size_t row = (size_t)b * SEQ + k1 + 128 * k2;
        const bf16_t* zp = qkv + row * LDQ + OFF_Z + 1536 + grp * 128 + 8 * g;
        bf16_t* op = A0 + row * DM + 1536 + grp * 128 + 8 * g;
#pragma unroll
        for (int k = 0; k < 4; ++k) {
            const u32x4 zv = *(const u32x4*)(zp + 32 * k);
            const f32x4 z0 = unpack4((u32x2){zv.x, zv.y}), z1 = unpack4((u32x2){zv.z, zv.w});
            *(bf16x8*)(op + 32 * k) = pack8(o2[2 * k] * silu4(z0), o2[2 * k + 1] * silu4(z1));
        }
        __syncthreads();
    }
}

__device__ void attn_phase(const bf16_t* qkv, const bf16_t* kcvc, const float* sink, bf16_t* A0, LAS unsigned char* lds) {
    const int tid = threadIdx.x, lane = tid & 63, w = __builtin_amdgcn_readfirstlane(tid >> 6), g = lane >> 4, li = lane & 15, qq = li >> 2, pp = li & 3;
    const int sr = tid >> 2, sc4 = tid & 3;
    const int vcu = (gridDim.x & 7) == 0 ? (int)(blockIdx.x & 7) * (int)(gridDim.x >> 3) + (int)(blockIdx.x >> 3) : (int)blockIdx.x;
    const int per = (1536 * REP_ATT + (int)gridDim.x - 1) / (int)gridDim.x;
    const int it_end = min((vcu + 1) * per, 1536 * REP_ATT);
    for (int it0 = vcu * per; it0 < it_end; ++it0) {
        const int it = it0 % 1536;
        const int h = it % 12, np = (it / 12) & 63, b = it / 768, kvh = h / 3;
        const size_t rowbase = (size_t)b * SEQ + np * 256 + 32 * w;
        bf16x8 qf[2][4]; float mrun[2], lrun[2]; f32x4 o[2][8];
        const float sk = sink[h] * LOG2E;
#pragma unroll
        for (int qt = 0; qt < 2; ++qt) {
            const bf16_t* qp = qkv + (rowbase + 16 * qt + li) * LDQ + h * 128 + 8 * g;
#pragma unroll
            for (int ks = 0; ks < 4; ++ks) qf[qt][ks] = *(const bf16x8*)(qp + 32 * ks);
            mrun[qt] = sk; lrun[qt] = (g == 0) ? 1.0f : 0.0f;
#pragma unroll
            for (int dt = 0; dt < 8; ++dt) o[qt][dt] = (f32x4){0.f, 0.f, 0.f, 0.f};
        }
        const int wstart = (np == 0) ? 1 : 0, wend = (np == 63) ? 3 : 4, cnt = 2 + (wend - wstart);
        u32x4 kr[4], vr[4];
#define ATT_LOAD(j) do { const bf16_t* kp_; \
            if ((j) < 2) kp_ = kcvc + ((size_t)b * 256 + 128 * (j) + sr) * 1024 + kvh * 128; \
            else kp_ = qkv + ((size_t)b * SEQ + np * 256 - 128 + ((j) - 2 + wstart) * 128 + sr) * LDQ + OFF_K + kvh * 128; \
            _Pragma("unroll") for (int i_ = 0; i_ < 4; ++i_) { kr[i_] = *(const u32x4*)(kp_ + (sc4 + 4 * i_) * 8); vr[i_] = *(const u32x4*)(kp_ + 512 + (sc4 + 4 * i_) * 8); } } while (0)
#define ATT_STORE(buf) do { LAS unsigned char* kd_ = lds + (buf) * 34816 + sr * 272 + sc4 * 16; LAS unsigned char* vd_ = lds + 69632 + (buf) * 36864 + sr * 288 + sc4 * 16; \
            _Pragma("unroll") for (int i_ = 0; i_ < 4; ++i_) { *(LAS u32x4*)(kd_ + 64 * i_) = kr[i_]; *(LAS u32x4*)(vd_ + 64 * i_) = vr[i_]; } } while (0)
        ATT_LOAD(0); ATT_STORE(0);
        __syncthreads();
        for (int j2 = 0; j2 < cnt; ++j2) {
            if (j2 + 1 < cnt) ATT_LOAD(j2 + 1);
#pragma unroll 1
          for (int hf = 0; hf < 2; ++hf) {
            const int tw = 2 * (j2 - 2 + wstart) + hf;
            const int kpos0 = np * 256 - 128 + tw * 64;
            const int q0 = np * 256 + 32 * w;
            const bool active = (j2 < 2) || (kpos0 + 63 >= q0 - 128 && kpos0 <= q0 + 31 + 128);
            if (active) {
                const bool needmask = (j2 >= 2) && !(kpos0 >= q0 + 31 - 128 && kpos0 + 63 <= q0 + 128);
                LAS unsigned char* kb = lds + (j2 & 1) * 34816 + hf * (64 * 272);
                LAS unsigned char* vb = lds + 69632 + (j2 & 1) * 36864 + hf * (64 * 288);
                f32x4 s[2][4];
#pragma unroll
                for (int qt = 0; qt < 2; ++qt)
#pragma unroll
                    for (int kt = 0; kt < 4; ++kt) s[qt][kt] = (f32x4){0.f, 0.f, 0.f, 0.f};
#pragma unroll
                for (int ks = 0; ks < 4; ++ks)
#pragma unroll
                    for (int kt = 0; kt < 4; ++kt) {
                        const bf16x8 kf = *(const LAS bf16x8*)(kb + (16 * kt + li) * 272 + (32 * ks + 8 * g) * 2);
#pragma unroll
                        for (int qt = 0; qt < 2; ++qt) s[qt][kt] = mfma16(kf, qf[qt][ks], s[qt][kt]);
                    }
                bf16x8 pf[2][2];
#pragma unroll
                for (int qt = 0; qt < 2; ++qt) {
                    if (needmask) {
                        const int qpos = np * 256 + 32 * w + 16 * qt + li;
#pragma unroll
                        for (int kt = 0; kt < 4; ++kt)
#pragma unroll
                            for (int r = 0; r < 4; ++r) { const int d = kpos0 + 16 * kt + 4 * g + r - qpos; if (d > 128 || d < -128) s[qt][kt][r] = -INFINITY; }
                    }
                    float mx = s[qt][0][0];
#pragma unroll
                    for (int kt = 0; kt < 4; ++kt)
#pragma unroll
                        for (int r = 0; r < 4; ++r) mx = fmaxf(mx, s[qt][kt][r]);
                    if (__builtin_amdgcn_ballot_w64(mx > mrun[qt] + 8.0f) != 0ull) {
                        mx = fmaxf(mx, __shfl_xor(mx, 16)); mx = fmaxf(mx, __shfl_xor(mx, 32));
                        const bool grow = mx > mrun[qt] + 8.0f;
                        const float mnew = grow ? mx : mrun[qt], alpha = __builtin_amdgcn_exp2f(mrun[qt] - mnew);
                        mrun[qt] = mnew; lrun[qt] *= alpha;
#pragma unroll
                        for (int dt = 0; dt < 8; ++dt) o[qt][dt] *= alpha;
                    }
                    const float mcur = mrun[qt];
                    float ls = 0.f;
#pragma unroll
                    for (int kt = 0; kt < 4; ++kt)
#pragma unroll
                        for (int r = 0; r < 4; ++r) { const float pe = __builtin_amdgcn_exp2f(s[qt][kt][r] - mcur); s[qt][kt][r] = pe; ls += pe; }
                    lrun[qt] += ls;
                    pf[qt][0] = pack8(s[qt][0], s[qt][1]); pf[qt][1] = pack8(s[qt][2], s[qt][3]);
                }
#pragma unroll
                for (int ks2 = 0; ks2 < 2; ++ks2)
#pragma unroll
                    for (int dt = 0; dt < 8; ++dt) {
                        LAS unsigned char* a = vb + (32 * ks2 + 4 * g + qq) * 288 + (32 * (dt >> 1) + 8 * pp + 4 * (dt & 1)) * 2;
                        const bf16x8 vf = tr2(a, a + 16 * 288);
#pragma unroll
                        for (int qt = 0; qt < 2; ++qt) o[qt][dt] = mfma16(vf, pf[qt][ks2], o[qt][dt]);
                    }
            }
          }
            if (j2 + 1 < cnt) ATT_STORE((j2 + 1) & 1);
            __syncthreads();
        }
#undef ATT_LOAD
#undef ATT_STORE
#pragma unroll
        for (int qt = 0; qt < 2; ++qt) {
            float lt = lrun[qt]; lt += __shfl_xor(lt, 16); lt += __shfl_xor(lt, 32);
            const float inv = 1.0f / lt;
            const bf16_t* zp = qkv + (rowbase + 16 * qt + li) * LDQ + OFF_Z + h * 128 + 8 * g;
            bf16_t* op = A0 + (rowbase + 16 * qt + li) * DM + h * 128 + 8 * g;
#pragma unroll
            for (int k = 0; k < 4; ++k) {
                const u32x4 zv = *(const u32x4*)(zp + 32 * k);
                const f32x4 z0 = unpack4((u32x2){zv.x, zv.y}), z1 = unpack4((u32x2){zv.z, zv.w});
                *(bf16x8*)(op + 32 * k) = pack8(o[qt][2 * k] * inv * silu4(z0), o[qt][2 * k + 1] * inv * silu4(z1));
            }
        }
    }
}

__device__ void pool_phase(const bf16_t* uz, const float* lscale, bf16_t* A1) {
    const int tid = threadIdx.x, sub = tid >> 8, colo = (tid & 255) * 8, grp = colo >> 9, half = 1 << grp;
    float ls[8];
#pragma unroll
    for (int e = 0; e < 8; ++e) ls[e] = lscale[colo + e];
    for (int job0 = blockIdx.x; job0 < 512 * REP_POOL; job0 += gridDim.x) {
        const int job = job0 & 511;
        const int b = job >> 8, t0 = (job & 255) * 64 + sub * 32;
        const bf16_t* ub = uz + (size_t)b * SEQ * 4096 + colo;
        float S[8];
#pragma unroll
        for (int e = 0; e < 8; ++e) S[e] = 0.f;
        const int lo0 = max(t0 - half, 0), hi0 = min(t0 + half, SEQ);
        for (int j = lo0; j < hi0; ++j) {
            const u32x4 v = *(const u32x4*)(ub + (size_t)j * 4096);
            S[0] += bflo(v.x); S[1] += bfhi(v.x); S[2] += bflo(v.y); S[3] += bfhi(v.y); S[4] += bflo(v.z); S[5] += bfhi(v.z); S[6] += bflo(v.w); S[7] += bfhi(v.w);
        }
        for (int tc = t0; tc < t0 + 32; tc += 4) {
            u32x4 uv[4], zv[4], ua[4], us[4];
#pragma unroll
            for (int i = 0; i < 4; ++i) {
                const int t = tc + i;
                uv[i] = *(const u32x4*)(ub + (size_t)t * 4096); zv[i] = *(const u32x4*)(ub + (size_t)t * 4096 + 2048);
                ua[i] = (t + half < SEQ) ? *(const u32x4*)(ub + (size_t)(t + half) * 4096) : (u32x4){0u, 0u, 0u, 0u};
                us[i] = (t - half >= 0) ? *(const u32x4*)(ub + (size_t)(t - half) * 4096) : (u32x4){0u, 0u, 0u, 0u};
            }
#pragma unroll
            for (int i = 0; i < 4; ++i) {
                const int t = tc + i;
                const int lo = max(t - half, 0), hi = min(t + half, SEQ);
                const float rc = 1.0f / (float)(hi - lo);
                const float u8[8] = {bflo(uv[i].x), bfhi(uv[i].x), bflo(uv[i].y), bfhi(uv[i].y), bflo(uv[i].z), bfhi(uv[i].z), bflo(uv[i].w), bfhi(uv[i].w)};
                const float z8[8] = {bflo(zv[i].x), bfhi(zv[i].x), bflo(zv[i].y), bfhi(zv[i].y), bflo(zv[i].z), bfhi(zv[i].z), bflo(zv[i].w), bfhi(zv[i].w)};
                float r8[8];
#pragma unroll
                for (int e = 0; e < 8; ++e) r8[e] = (S[e] * rc - u8[e]) * ls[e] * silu(z8[e]);
                u32x4 wv; wv.x = cvt_pk_bf16(r8[0], r8[1]); wv.y = cvt_pk_bf16(r8[2], r8[3]); wv.z = cvt_pk_bf16(r8[4], r8[5]); wv.w = cvt_pk_bf16(r8[6], r8[7]);
                *(u32x4*)(A1 + ((size_t)b * SEQ + t) * DM + colo) = wv;
                S[0] += bflo(ua[i].x) - bflo(us[i].x); S[1] += bfhi(ua[i].x) - bfhi(us[i].x); S[2] += bflo(ua[i].y) - bflo(us[i].y); S[3] += bfhi(ua[i].y) - bfhi(us[i].y);
                S[4] += bflo(ua[i].z) - bflo(us[i].z); S[5] += bfhi(ua[i].z) - bfhi(us[i].z); S[6] += bflo(ua[i].w) - bflo(us[i].w); S[7] += bfhi(ua[i].w) - bfhi(us[i].w);
            }
        }
    }
}

__device__ __forceinline__ void grid_bar(unsigned* cnt, unsigned target) {
    asm volatile("s_waitcnt vmcnt(0)" ::: "memory");
    __syncthreads();
    if (threadIdx.x == 0) {
        __builtin_amdgcn_fence(__ATOMIC_RELEASE, "agent");
        asm volatile("s_waitcnt vmcnt(0)" ::: "memory");
        (void)__hip_atomic_fetch_add(cnt, 1u, __ATOMIC_RELAXED, __HIP_MEMORY_SCOPE_AGENT);
        unsigned sp = 0;
        while (__hip_atomic_load(cnt, __ATOMIC_RELAXED, __HIP_MEMORY_SCOPE_AGENT) < target) { __builtin_amdgcn_s_sleep(1); if (++sp > (1u << 24)) break; }
        __builtin_amdgcn_fence(__ATOMIC_ACQUIRE, "agent");
        asm volatile("s_waitcnt vmcnt(0)" ::: "memory");
    }
    __syncthreads();
}

#define XB_TMO      128
#define XB_XCNT(j)  (256  + 64 * (j))
#define XB_XSUB(j)  (1280 + 64 * (j))
#define XB_XGEN(j)  (2304 + 64 * (j))
#define XB_TOP      3328
#define XB_TOPGEN   3392
#define XB_SPIN_CAP (1u << 22)
__device__ __forceinline__ unsigned xb_ld(unsigned* p)              { return __hip_atomic_load(p, __ATOMIC_RELAXED, __HIP_MEMORY_SCOPE_AGENT); }
__device__ __forceinline__ unsigned xb_add(unsigned* p, unsigned v) { return __hip_atomic_fetch_add(p, v, __ATOMIC_RELAXED, __HIP_MEMORY_SCOPE_AGENT); }
__device__ __forceinline__ unsigned xb_xcc_id() { return (unsigned)__builtin_amdgcn_s_getreg((3 << 11) | 20) & 0xFu; }
#define XB_SPIN(cond, bar) do { unsigned _sp = 0; while (cond) { __builtin_amdgcn_s_sleep(1); \
    if ((++_sp & 255u) == 0u) { if (xb_ld(&(bar)[XB_TMO])) break; if (_sp > XB_SPIN_CAP) { atomicAdd(&(bar)[XB_TMO], 1u); break; } } } } while (0)
struct XcdBar { unsigned* bar; unsigned x, nloc, nx; };
__device__ __forceinline__ void xcd_bar(XcdBar& b) {
    asm volatile("s_waitcnt vmcnt(0)" ::: "memory");
    __syncthreads();
    if (threadIdx.x == 0) {
        unsigned* bar = b.bar;
        __builtin_amdgcn_s_waitcnt(0);
        if (b.nloc == 0u) {
            const unsigned G = gridDim.x; unsigned sum, cnt, mine, sp = 0u;
            for (;;) {
                sum = 0u; cnt = 0u; mine = 0u;
#pragma unroll
                for (unsigned j = 0; j < 16; ++j) { const unsigned c = xb_ld(&bar[XB_XCNT(j)]); sum += c; cnt += (c > 0u) ? 1u : 0u; mine = (j == b.x) ? c : mine; }
                if (sum == G) break;
                __builtin_amdgcn_s_sleep(1);
                if ((++sp & 255u) == 0u) { if (xb_ld(&bar[XB_TMO])) break; if (sp > XB_SPIN_CAP) { atomicAdd(&bar[XB_TMO], 1u); break; } }
            }
            b.nloc = mine > 0u ? mine : 1u; b.nx = cnt > 0u ? cnt : 1u;
        }
        const unsigned nloc = b.nloc, nx = b.nx;
        const unsigned old = xb_add(&bar[XB_XSUB(b.x)], 1u);
        const unsigned gen = old / nloc;
        if (old + 1u == (gen + 1u) * nloc) {
            __builtin_amdgcn_fence(__ATOMIC_RELEASE, "agent");
            asm volatile("s_waitcnt vmcnt(0)" ::: "memory");
            const unsigned og = xb_add(&bar[XB_TOP], 1u);
            const unsigned tg = og / nx;
            if (og + 1u == (tg + 1u) * nx) xb_add(&bar[XB_TOPGEN], 1u);
            else XB_SPIN(xb_ld(&bar[XB_TOPGEN]) == tg, bar);
            __builtin_amdgcn_fence(__ATOMIC_ACQUIRE, "agent");
            xb_add(&bar[XB_XGEN(b.x)], 1u);
            asm volatile("s_waitcnt vmcnt(0)" ::: "memory");
        } else {
            XB_SPIN(xb_ld(&bar[XB_XGEN(b.x)]) == gen, bar);
            __builtin_amdgcn_fence(__ATOMIC_ACQUIRE, "agent");
            asm volatile("s_waitcnt vmcnt(0)" ::: "memory");
        }
    }
    __syncthreads();
}

__global__ void __launch_bounds__(512, 2) fwd_mega(Params p) {
    extern __shared__ __attribute__((aligned(16))) unsigned char lds_raw[];
    LAS unsigned char* lds = (LAS unsigned char*)lds_raw;
    cg::grid_group grid = cg::this_grid();
    unsigned char* ws = p.ws;
    const float* mod = (const float*)(ws + WS_MOD);
    const f32x2* rope = (const f32x2*)(ws + WS_ROPE);
    bf16_t* Dc = (bf16_t*)(ws + WS_DC); bf16_t* Ec = (bf16_t*)(ws + WS_EC); bf16_t* MgT = (bf16_t*)(ws + WS_MGT);
    bf16_t* WtIn0 = (bf16_t*)(ws + WS_WTIN0); bf16_t* WtOut0 = (bf16_t*)(ws + WS_WTOUT0); bf16_t* WtIn1 = (bf16_t*)(ws + WS_WTIN1); bf16_t* WtOut1 = (bf16_t*)(ws + WS_WTOUT1);
    bf16_t* Wbf1 = (bf16_t*)(ws + WS_WBF1); bf16_t* WgrpT = (bf16_t*)(ws + WS_WGRPT);
    bf16_t* H = (bf16_t*)(ws + WS_H); bf16_t* HC = (bf16_t*)(ws + WS_HC); bf16_t* QKV = (bf16_t*)(ws + WS_QKV); bf16_t* KCVC = (bf16_t*)(ws + WS_KCVC);
    bf16_t* Y = (bf16_t*)(ws + WS_Y); bf16_t* AB = (bf16_t*)(ws + WS_A);
    float* RSS = (float*)(ws + WS_RSS); float* BIAS1 = (float*)(ws + WS_BIAS1);
    const int G = gridDim.x, bid = blockIdx.x;

    unsigned* barcnt = (unsigned*)(ws + WS_BAR); unsigned nbar = 0;
    XcdBar xbar; xbar.bar = (unsigned*)(ws + WS_XBAR); xbar.x = xb_xcc_id(); xbar.nloc = 0u; xbar.nx = 0u;
    if (threadIdx.x == 0) (void)xb_add(&xbar.bar[XB_XCNT(xbar.x)], 1u);
#ifdef USE_CG_SYNC
#define GRID_BAR() grid.sync()
#else
#ifdef USE_FLAT_BAR
#define GRID_BAR() do { ++nbar; grid_bar(barcnt, nbar * (unsigned)G); } while (0)
#else
#define GRID_BAR() xcd_bar(xbar)
#endif
#endif
    phase0(p, lds);
#if REP_P0 > 1
    __syncthreads(); phase0(p, lds); __syncthreads(); phase0(p, lds);
#endif
#ifdef USE_CG_SYNC
    grid.sync();
#else
    if (p.ws == nullptr) grid.sync();
    GRID_BAR();
#endif

    norm_mod_phase(p.x, H, p.l0_norm, mod, p.ctx, HC);
    GRID_BAR();

    {
        pg8::Gemm g{H, WtIn0, MTOK, 5120, 2048, 2048, 2048}; pg8::StaticOrder S; S.init(MTOK, 5120, G, bid);
        EpiB<1> E{QKV, LDQ, rope};
        pg8::gemm_phase<EpiB<1>, pg8::StaticOrder, false>(lds, g, S, E, nullptr);
#if REP_G0 > 1
        pg8::gemm_phase<EpiB<1>, pg8::StaticOrder, false>(lds, g, S, E, nullptr);
#endif
    }
    GRID_BAR();

    {
        pg8::Gemm g{HC, WtIn0 + (size_t)OFF_K * 2048, 512, 1024, 2048, 2048, 2048}; pg8::StaticOrder S; S.init(512, 1024, G, bid);
        EpiB<0> E{KCVC, 1024, nullptr};
        pg8::gemm_phase<EpiB<0>, pg8::StaticOrder, false>(lds, g, S, E, nullptr);
    }
    {
        const int fbk = (bid - 8) & 63, grp = fbk >> 4, wi = fbk & 15;
        pg8::Gemm g{WgrpT + (size_t)grp * 262144, Wbf1 + grp * 512, 512, 2048, 512, 512, 2048};
        OneUnit S{(G >= 72 ? (bid >= 8 && bid < 72) : (bid < 64)) ? 1 : 0, {wi >> 3, wi & 7}};
        EpiB<0> E{WtIn1 + (size_t)grp * 512 * 2048, 2048, nullptr};
        pg8::gemm_phase<EpiB<0>, OneUnit, false>(lds, g, S, E, nullptr);
    }
    fourier_a_phase(QKV, Dc, Y, lds);
    GRID_BAR();

    bias1_phase(WtIn1, mod + 3 * 6144, BIAS1);
    attn_phase(QKV, KCVC, p.l0_sink, AB, lds);
#if REP_P4 == 2
    attn_phase(QKV, KCVC, p.l0_sink, AB, lds);
#endif
    fourier_b_phase(Y, Ec, MgT, QKV, AB, lds);
#if REP_P4 == 3
    fourier_b_phase(Y, Ec, MgT, QKV, AB, lds);
#endif
#if REP_P4 == 4
    GRID_BAR();
    attn_phase(QKV, KCVC, p.l0_sink, AB, lds);
#endif
    GRID_BAR();

    {
        pg8::Gemm g{AB, WtOut0, MTOK, 2048, 2048, 2048, 2048}; pg8::StaticOrder S; S.init(MTOK, 2048, G, bid);
        EpiResNext E{p.x, p.out, mod + 4096, H, p.l1_norm, mod + 3 * 6144 + 2048, RSS};
        pg8::gemm_phase<EpiResNext, pg8::StaticOrder, false>(lds, g, S, E, nullptr);
    }
    GRID_BAR();

    {
        pg8::Gemm g{H, WtIn1, MTOK, 4096, 2048, 2048, 2048}; pg8::StaticOrder S; S.init(MTOK, 4096, G, bid);
        EpiBNorm E{QKV, 4096, RSS, BIAS1};
        pg8::gemm_phase<EpiBNorm, pg8::StaticOrder, false>(lds, g, S, E, nullptr);
#if REP_G2 > 1
        pg8::gemm_phase<EpiBNorm, pg8::StaticOrder, false>(lds, g, S, E, nullptr);
#endif
    }
    GRID_BAR();

#if REP_MEM > 1
    pool_phase(QKV, p.l1_scale, AB);
#endif
    pool_phase(QKV, p.l1_scale, AB);
    GRID_BAR();

    {
        pg8::Gemm g{AB, WtOut1, MTOK, 2048, 2048, 2048, 2048}; pg8::StaticOrder S; S.init(MTOK, 2048, G, bid);
        EpiGateB E{H, mod + 3 * 6144 + 4096};
        pg8::gemm_phase<EpiGateB, pg8::StaticOrder, false>(lds, g, S, E, nullptr);
    }
    GRID_BAR();

#ifdef REP_SYNC
    for (int rep = 0; rep < REP_SYNC; ++rep) GRID_BAR();
#endif
    final_norm_phase(p.out, H, p.final_norm);
}

extern "C" void kernel_launch(void* const* d_in, const int* in_sizes, int n_in, void* d_out, int out_size, void* d_ws, size_t ws_size, hipStream_t stream) {
    static int grid_blocks = 0;
    if (!grid_blocks) {
        int dev = 0, cus = 0, per_cu = 0;
        (void)hipGetDevice(&dev);
        (void)hipDeviceGetAttribute(&cus, hipDeviceAttributeMultiprocessorCount, dev);
        (void)hipFuncSetAttribute((const void*)fwd_mega, hipFuncAttributeMaxDynamicSharedMemorySize, LDS_BYTES);
        (void)hipOccupancyMaxActiveBlocksPerMultiprocessor(&per_cu, (const void*)fwd_mega, 512, LDS_BYTES);
        if (per_cu < 1) per_cu = 1;
        grid_blocks = cus * per_cu;
        if (ws_size < WS_END) fprintf(stderr, "kernel_launch: workspace too small (%zu < %zu)\n", ws_size, (size_t)WS_END);
    }
    Params p{};
    p.x = (const float*)d_in[0]; p.c = (const float*)d_in[1]; p.ctx = (const float*)d_in[2]; p.c_ctx = (const float*)d_in[3];
    p.l0_norm = (const float*)d_in[4]; p.l0_w_mod = (const float*)d_in[5]; p.l0_b_mod = (const float*)d_in[6]; p.l0_w_in = (const float*)d_in[7];
    p.l0_sink = (const float*)d_in[8]; p.l0_w_f = (const float*)d_in[9]; p.l0_w_out = (const float*)d_in[10];
    p.l1_norm = (const float*)d_in[11]; p.l1_w_mod = (const float*)d_in[12]; p.l1_b_mod = (const float*)d_in[13]; p.l1_w_in = (const float*)d_in[14];
    p.l1_w_grp = (const float*)d_in[15]; p.l1_scale = (const float*)d_in[16]; p.l1_w_out = (const float*)d_in[17]; p.final_norm = (const float*)d_in[18];
    p.out = (float*)d_out; p.ws = (unsigned char*)d_ws;
#ifndef USE_CG_SYNC
    (void)hipMemsetAsync((char*)d_ws + WS_XBAR, 0, 16384, stream);
#endif
    void* args[] = {&p};
    hipError_t e = hipLaunchCooperativeKernel((void*)fwd_mega, dim3(grid_blocks), dim3(512), args, LDS_BYTES, stream);
    if (e != hipSuccess) fprintf(stderr, "cooperative launch failed: %s (grid %d)\n", hipGetErrorString(e), grid_blocks);
}
```

```cpp
#include <hip/hip_runtime.h>
#include <hip/hip_cooperative_groups.h>
#include <cstdio>
namespace cg = cooperative_groups;

namespace pg8 {
#define PG8_LAS __attribute__((address_space(3)))
typedef unsigned short bf16_t;
typedef short bf16x8 __attribute__((ext_vector_type(8)));
typedef float f32x4 __attribute__((ext_vector_type(4)));
typedef unsigned u32x4 __attribute__((ext_vector_type(4)));
constexpr int BM = 256, BK = 64, HALF = 128, HTB = HALF * BK * 2  , STAGE_BYTES = 8 * HTB, NXCD = 8, WGM = 8;

__host__ __device__ __forceinline__ int lds_byte(int r, int c) { const int st = (r >> 4) * 2 + (c >> 5), rr = r & 15, cc = c & 31, ob = rr * 64 + cc * 2; return st * 1024 + (ob ^ (((ob >> 9) & 1) << 5)); }
__host__ __device__ __forceinline__ void stage_rc(int b, int& R, int& C) { const int st = b / 1024, sb = b % 1024, swz = sb ^ (((sb >> 9) & 1) << 5); R = (st >> 1) * 16 + swz / 64; C = (st & 1) * 32 + (swz % 64) / 2; }
__host__ __device__ __forceinline__ int perm32(int rho) { const int n = rho >> 4, i = rho & 15; return 8 * (i >> 2) + 4 * n + (i & 3); }

struct Unit { int pm, pn; };
struct Gemm { const bf16_t* A; const bf16_t* Bt; int M, N, K, lda, ldb; };

struct StaticOrder {
    int nM, nN, nwg, G, c;
    __host__ __device__ void init(int M, int N, int G_, int c_) { nM = M / BM; nN = N / BM; nwg = nM * nN; G = G_; c = c_; }
    __host__ __device__ bool next(int i, Unit& u) const {
        const long L = (long)i * G + c; if (L >= nwg) return false;
        int wgid = (int)L; { const int q = nwg / NXCD, r = nwg % NXCD, xcd = wgid % NXCD, off = wgid / NXCD; wgid = (xcd < r ? xcd * (q + 1) : r * (q + 1) + (xcd - r) * q) + off; }
        const int nig = WGM * nN, gid = wgid / nig, fm = gid * WGM, gsz = (nM - fm) < WGM ? (nM - fm) : WGM;
        u.pm = fm + ((wgid % nig) % gsz); u.pn = (wgid % nig) / gsz; return true;
    }
    __device__ __forceinline__ void a_ready(const Unit&) const {}
    __device__ __forceinline__ void done(const Unit&) const {}
};
__device__ __forceinline__ unsigned cvt_pk_bf16(float lo, float hi) { unsigned r; asm("v_cvt_pk_bf16_f32 %0, %1, %2" : "=v"(r) : "v"(lo), "v"(hi)); return r; }
template <class Epi, class Sched, bool STAMP = false>
__device__ __forceinline__ void gemm_phase(PG8_LAS unsigned char* lds, const Gemm g, const Sched& S, const Epi& E, unsigned long long* stamps) {
    const int tid = threadIdx.x, wid = __builtin_amdgcn_readfirstlane(tid >> 6), lane = tid & 63, wr = wid >> 2, wc = wid & 3, fr = lane & 15, fq = lane >> 4;
    const int K = g.K, nt = K / BK;
    int ts_lo = 0, ts_hi = 0, nts = 0; const unsigned long long rt_entry = STAMP ? (unsigned long long)wall_clock64() : 0ull;
#define PG8_STAMP() do { if (STAMP && wid == 0 && nts < 64) { const unsigned long long _c = (unsigned long long)clock64(); \
        ts_lo = (lane == nts) ? (int)(unsigned)_c : ts_lo; ts_hi = (lane == nts) ? (int)(unsigned)(_c >> 32) : ts_hi; ++nts; } } while (0)
    PG8_STAMP();
    unsigned voffA[2], voffB[2];
#pragma unroll
    for (int i = 0; i < 2; ++i) { int R, C; stage_rc(tid * 16 + i * 8192, R, C); const int Rb = Epi::PERM ? ((R & ~31) + perm32(R & 31)) : R;
        voffA[i] = (unsigned)(R * g.lda + C) * 2u; voffB[i] = (unsigned)(Rb * g.ldb + C) * 2u; }
    const size_t kstep = (size_t)(BK * 2);
    const size_t hstepA = (size_t)HALF * g.lda * 2, hstepB = (size_t)HALF * g.ldb * 2;
    const size_t tstepA = 2 * hstepA, tstepB = 2 * hstepB;
    const unsigned ldsw = (unsigned)wid * 1024u;
    const int aoff = lds_byte(wr * 64 + fr, fq * 8), boff = lds_byte(wc * 32 + fr, fq * 8);
#define PG8_SA(b, h) (((b) * 2 + (h)) * HTB)
#define PG8_SB(b, h) ((4 + (b) * 2 + (h)) * HTB)
#define PG8_STAGE(bufoff, gbase, voff) do { _Pragma("unroll") for (int _i = 0; _i < 2; ++_i) \
        __builtin_amdgcn_global_load_lds((const unsigned*)((const char*)(gbase) + (voff)[_i]), (PG8_LAS unsigned*)(lds + (bufoff) + ldsw + _i * 8192), 16, 0, 0); } while (0)
#define PG8_LDA(dst, b, h) do { _Pragma("unroll") for (int m = 0; m < 4; ++m) _Pragma("unroll") for (int k = 0; k < 2; ++k) dst[m][k] = *(const PG8_LAS bf16x8*)(lds + PG8_SA(b, h) + aoff + m * 2048 + k * 1024); } while (0)
#define PG8_LDB(dst, b, h) do { _Pragma("unroll") for (int n = 0; n < 2; ++n) _Pragma("unroll") for (int k = 0; k < 2; ++k) dst[n][k] = *(const PG8_LAS bf16x8*)(lds + PG8_SB(b, h) + boff + n * 2048 + k * 1024); } while (0)
#define PG8_MMA(ai, bj, At, Bt) do { __builtin_amdgcn_s_setprio(1); _Pragma("unroll") for (int m = 0; m < 4; ++m) _Pragma("unroll") for (int n = 0; n < 2; ++n) _Pragma("unroll") for (int k = 0; k < 2; ++k) \
        acc[ai][bj][m][n] = __builtin_amdgcn_mfma_f32_16x16x32_bf16(Bt[n][k], At[m][k], acc[ai][bj][m][n], 0, 0, 0); __builtin_amdgcn_s_setprio(0); } while (0)
#define PG8_WAIT_V(n) asm volatile("s_waitcnt vmcnt(" #n ")" ::: "memory")
#define PG8_WAIT_L(n) asm volatile("s_waitcnt lgkmcnt(" #n ")" ::: "memory")
#define PG8_BAR __builtin_amdgcn_s_barrier()
#define PG8_SCHED __builtin_amdgcn_sched_barrier(0)
    Unit cur, nxt; int ui = 0;
    if (!S.next(0, cur)) return;
    f32x4 acc[2][2][4][2];
#pragma unroll
    for (int a = 0; a < 2; ++a)
#pragma unroll
        for (int b = 0; b < 2; ++b)
#pragma unroll
            for (int m = 0; m < 4; ++m)
#pragma unroll
                for (int n = 0; n < 2; ++n) acc[a][b][m][n] = (f32x4){0.f, 0.f, 0.f, 0.f};
    bf16x8 At[4][2], B0[2][2], B1[2][2];
    const char* cA = (const char*)g.A + (size_t)cur.pm * tstepA; const char* cB = (const char*)g.Bt + (size_t)cur.pn * tstepB;
    S.a_ready(cur);
    PG8_STAGE(PG8_SB(0, 0), cB, voffB); PG8_STAGE(PG8_SA(0, 0), cA, voffA); PG8_STAGE(PG8_SB(0, 1), cB + hstepB, voffB); PG8_STAGE(PG8_SA(0, 1), cA + hstepA, voffA);
    if (wr == 1) PG8_BAR;
    PG8_WAIT_V(4); PG8_BAR;
    PG8_STAGE(PG8_SB(1, 0), cB + kstep, voffB); PG8_STAGE(PG8_SA(1, 0), cA + kstep, voffA); PG8_STAGE(PG8_SB(1, 1), cB + hstepB + kstep, voffB);
    PG8_WAIT_V(6); PG8_BAR;
    PG8_STAMP();
    for (;;) {
        const bool has_next = S.next(ui + 1, nxt);
        const char* nA = has_next ? (const char*)g.A + (size_t)nxt.pm * tstepA : cA; const char* nB = has_next ? (const char*)g.Bt + (size_t)nxt.pn * tstepB : cB;
        for (int t = 0; t < nt; t += 2) {
            const bool last = (t == nt - 2);
            const char* a1 = cA + (size_t)(t + 1) * kstep;
            const char* a2 = last ? nA : cA + (size_t)(t + 2) * kstep; const char* b2 = last ? nB : cB + (size_t)(t + 2) * kstep;
            const char* a3 = a2 + kstep; const char* b3 = b2 + kstep;
            if (last && has_next) S.a_ready(nxt);
            PG8_LDB(B0, 0, 0); PG8_SCHED; PG8_LDA(At, 0, 0); PG8_STAGE(PG8_SA(1, 1), a1 + hstepA, voffA);
            PG8_WAIT_L(8); PG8_BAR; PG8_WAIT_L(0); PG8_MMA(0, 0, At, B0); PG8_BAR; PG8_SCHED;
            PG8_LDB(B1, 0, 1); PG8_STAGE(PG8_SB(0, 0), b2, voffB);
            PG8_BAR; PG8_WAIT_L(0); PG8_MMA(0, 1, At, B1); PG8_BAR;
            PG8_LDA(At, 0, 1); PG8_STAGE(PG8_SA(0, 0), a2, voffA);
            PG8_BAR; PG8_WAIT_L(0); PG8_MMA(1, 0, At, B0); PG8_BAR; PG8_SCHED;
            PG8_STAGE(PG8_SB(0, 1), b2 + hstepB, voffB);
            PG8_WAIT_V(6); PG8_BAR; PG8_MMA(1, 1, At, B1); PG8_BAR;
            PG8_LDB(B0, 1, 0); PG8_SCHED; PG8_LDA(At, 1, 0); PG8_STAGE(PG8_SA(0, 1), a2 + hstepA, voffA);
            PG8_WAIT_L(8); PG8_BAR; PG8_WAIT_L(0); PG8_MMA(0, 0, At, B0); PG8_BAR; PG8_SCHED;
            PG8_LDB(B1, 1, 1); PG8_STAGE(PG8_SB(1, 0), b3, voffB);
            PG8_BAR; PG8_WAIT_L(0); PG8_MMA(0, 1, At, B1); PG8_BAR;
            PG8_LDA(At, 1, 1); PG8_STAGE(PG8_SA(1, 0), a3, voffA);
            PG8_BAR; PG8_WAIT_L(0); PG8_MMA(1, 0, At, B0); PG8_BAR; PG8_SCHED;
            PG8_STAGE(PG8_SB(1, 1), b3 + hstepB, voffB);
            PG8_WAIT_V(6); PG8_BAR; PG8_MMA(1, 1, At, B1); PG8_BAR;
        }
        PG8_STAMP();
        if constexpr (!Epi::AFTER_DRAIN) { E(acc, cur, wr, wc, fr, fq); S.done(cur); }
        PG8_STAMP();
        if (!has_next) break;
#pragma unroll
        for (int a = 0; a < 2; ++a)
#pragma unroll
            for (int b = 0; b < 2; ++b)
#pragma unroll
                for (int m = 0; m < 4; ++m)
#pragma unroll
                    for (int n = 0; n < 2; ++n) acc[a][b][m][n] = (f32x4){0.f, 0.f, 0.f, 0.f};
        cur = nxt; cA = nA; cB = nB; ++ui;
    }
    PG8_WAIT_V(0);
    if (wr == 0) PG8_BAR;
    PG8_BAR;
    if constexpr (Epi::AFTER_DRAIN) { E.fused(acc, cur, wr, wc, fr, fq, lds, wid, lane); S.done(cur); }
    PG8_STAMP();
    if (STAMP && wid == 0) { stamps[lane] = lane < nts ? (((unsigned long long)(unsigned)ts_hi << 32) | (unsigned)ts_lo) : 0ull;
        if (lane == 62) stamps[62] = rt_entry; if (lane == 63) stamps[63] = (unsigned long long)wall_clock64(); }
#undef PG8_STAMP
#undef PG8_SA
#undef PG8_SB
#undef PG8_STAGE
#undef PG8_LDA
#undef PG8_LDB
#undef PG8_MMA
#undef PG8_WAIT_V
#undef PG8_WAIT_L
#undef PG8_BAR
#undef PG8_SCHED
}
}

#define LAS __attribute__((address_space(3)))
using pg8::bf16_t; using pg8::bf16x8; using pg8::f32x4; using pg8::u32x4; using pg8::cvt_pk_bf16;
typedef short s16x4 __attribute__((ext_vector_type(4)));
typedef unsigned u32x2 __attribute__((ext_vector_type(2)));
typedef float f32x2 __attribute__((ext_vector_type(2)));

constexpr int DM = 2048, SEQ = 16384, MTOK = 32768;
constexpr int LDQ = 5120;
constexpr int OFF_K = 1536, OFF_V = 2048, OFF_F = 2560, OFF_Z = 3072;
constexpr float LOG2E = 1.4426950408889634f;
constexpr float QSCALE = 0.08838834764831845f * 1.4426950408889634f;
constexpr int LDS_BYTES = 143360;
#ifndef REP_ATT
#define REP_ATT 1
#endif
#ifndef REP_FA
#define REP_FA 1
#endif
#ifndef REP_FB
#define REP_FB 1
#endif
#ifndef REP_POOL
#define REP_POOL 1
#endif
#ifndef REP_P0
#define REP_P0 1
#endif
#ifndef REP_G0
#define REP_G0 1
#endif
#ifndef REP_P4
#define REP_P4 1
#endif
#ifndef REP_G2
#define REP_G2 1
#endif
#ifndef REP_MEM
#define REP_MEM 1
#endif

constexpr size_t WS_BAR = 0;
constexpr size_t WS_MOD = 256;
constexpr size_t WS_ROPE = WS_MOD + 147456;
constexpr size_t WS_DC = WS_ROPE + 81920;
constexpr size_t WS_EC = WS_DC + 65536;
constexpr size_t WS_MGT = WS_EC + 131072;
constexpr size_t WS_WTIN0 = WS_MGT + 262144;
constexpr size_t WS_WTOUT0 = WS_WTIN0 + 20971520;
constexpr size_t WS_WTIN1 = WS_WTOUT0 + 8388608;
constexpr size_t WS_WTOUT1 = WS_WTIN1 + 16777216;
constexpr size_t WS_WBF1 = WS_WTOUT1 + 8388608;
constexpr size_t WS_WGRPT = WS_WBF1 + 8388608;
constexpr size_t WS_H = WS_WGRPT + 2097152;
constexpr size_t WS_HC = WS_H + 134217728;
constexpr size_t WS_QKV = WS_HC + 2097152;
constexpr size_t WS_KCVC = WS_QKV + 335544320;
constexpr size_t WS_Y = WS_KCVC + 1048576;
constexpr size_t WS_A = WS_Y + 67108864;
constexpr size_t WS_RSS = WS_A + 134217728;
constexpr size_t WS_BIAS1 = WS_RSS + 131072;
constexpr size_t WS_XBAR = WS_BIAS1 + 32768;
constexpr size_t WS_END = WS_XBAR + 16384;

struct Params {
    const float *x, *c, *ctx, *c_ctx;
    const float *l0_norm, *l0_w_mod, *l0_b_mod, *l0_w_in, *l0_sink, *l0_w_f, *l0_w_out;
    const float *l1_norm, *l1_w_mod, *l1_b_mod, *l1_w_in, *l1_w_grp, *l1_scale, *l1_w_out, *final_norm;
    float* out; unsigned char* ws;
};

__device__ __forceinline__ float bflo(unsigned u) { return __uint_as_float(u << 16); }
__device__ __forceinline__ float bfhi(unsigned u) { return __uint_as_float(u & 0xffff0000u); }
__device__ __forceinline__ unsigned short f2bf(float f) { return (unsigned short)(cvt_pk_bf16(f, f) & 0xffffu); }
__device__ __forceinline__ float silu(float v) { return v * __builtin_amdgcn_rcpf(1.0f + __expf(-v)); }
__device__ __forceinline__ f32x4 mfma16(bf16x8 a, bf16x8 b, f32x4 c) { return __builtin_amdgcn_mfma_f32_16x16x32_bf16(a, b, c, 0, 0, 0); }
__device__ __forceinline__ bf16x8 tr2(LAS unsigned char* p0, LAS unsigned char* p1) {
    const s16x4 a = __builtin_amdgcn_ds_read_tr16_b64_v4i16((LAS s16x4*)p0);
    const s16x4 b = __builtin_amdgcn_ds_read_tr16_b64_v4i16((LAS s16x4*)p1);
    return __builtin_shufflevector(a, b, 0, 1, 2, 3, 4, 5, 6, 7);
}
__device__ __forceinline__ bf16x8 pack8(f32x4 a, f32x4 b) {
    u32x4 w; w.x = cvt_pk_bf16(a[0], a[1]); w.y = cvt_pk_bf16(a[2], a[3]); w.z = cvt_pk_bf16(b[0], b[1]); w.w = cvt_pk_bf16(b[2], b[3]);
    return __builtin_bit_cast(bf16x8, w);
}
__device__ __forceinline__ u32x2 pack4(f32x4 a) { u32x2 w; w.x = cvt_pk_bf16(a[0], a[1]); w.y = cvt_pk_bf16(a[2], a[3]); return w; }
__device__ __forceinline__ f32x4 unpack4(u32x2 w) { return (f32x4){bflo(w.x), bfhi(w.x), bflo(w.y), bfhi(w.y)}; }
__device__ __forceinline__ f32x4 silu4(f32x4 z) { return (f32x4){silu(z[0]), silu(z[1]), silu(z[2]), silu(z[3])}; }

template <int MODE> struct EpiB {
    static constexpr bool PERM = true, AFTER_DRAIN = false;
    bf16_t* O; int ldc; const f32x2* rope;
    __device__ __forceinline__ void operator()(const f32x4 (&acc)[2][2][4][2], const pg8::Unit& u, int wr, int wc, int fr, int fq) const {
        const int row0 = u.pm * 256 + wr * 64 + fr, col0 = u.pn * 256 + wc * 32 + 8 * fq;
#pragma unroll
        for (int ai = 0; ai < 2; ++ai)
#pragma unroll
            for (int m = 0; m < 4; ++m) {
                const int row = row0 + ai * 128 + m * 16;
                bf16_t* rowp = O + (size_t)row * ldc + col0;
#pragma unroll
                for (int bj = 0; bj < 2; ++bj) {
                    f32x4 v0 = acc[ai][bj][m][0], v1 = acc[ai][bj][m][1];
                    if (MODE == 1 && u.pn < 8) {
                        const int s = row & (SEQ - 1);
                        const int t0 = ((col0 + bj * 128) & 127) >> 1;
                        const f32x2* tp = rope + (t0 < 32 ? ((s >> 6) * 32 + t0) : ((256 + (s & 63)) * 32 + (t0 - 32)));
                        const f32x4 c01 = *(const f32x4*)tp, c23 = *(const f32x4*)(tp + 2);
                        const float sc = (u.pn < 6) ? QSCALE : 1.0f;
                        f32x4 r0, r1;
                        r0[0] = (v0[0] * c01[0] - v0[1] * c01[1]) * sc; r0[1] = (v0[1] * c01[0] + v0[0] * c01[1]) * sc;
                        r0[2] = (v0[2] * c01[2] - v0[3] * c01[3]) * sc; r0[3] = (v0[3] * c01[2] + v0[2] * c01[3]) * sc;
                        r1[0] = (v1[0] * c23[0] - v1[1] * c23[1]) * sc; r1[1] = (v1[1] * c23[0] + v1[0] * c23[1]) * sc;
                        r1[2] = (v1[2] * c23[2] - v1[3] * c23[3]) * sc; r1[3] = (v1[3] * c23[2] + v1[2] * c23[3]) * sc;
                        v0 = r0; v1 = r1;
                    }
                    u32x4 w; w.x = cvt_pk_bf16(v0[0], v0[1]); w.y = cvt_pk_bf16(v0[2], v0[3]); w.z = cvt_pk_bf16(v1[0], v1[1]); w.w = cvt_pk_bf16(v1[2], v1[3]);
                    *(u32x4*)(rowp + bj * 128) = w;
                }
            }
    }
};
struct EpiRes {
    static constexpr bool PERM = false, AFTER_DRAIN = false;
    const float* base; float* out; const float* gate;
    __device__ __forceinline__ void operator()(const f32x4 (&acc)[2][2][4][2], const pg8::Unit& u, int wr, int wc, int fr, int fq) const {
        const int row0 = u.pm * 256 + wr * 64 + fr, col0 = u.pn * 256 + wc * 32 + 4 * fq;
        const float* gp = gate + (size_t)(u.pm >> 6) * 6144 + col0;
        f32x4 gv[2][2];
#pragma unroll
        for (int bj = 0; bj < 2; ++bj)
#pragma unroll
            for (int n = 0; n < 2; ++n) gv[bj][n] = *(const f32x4*)(gp + bj * 128 + n * 16);
#pragma unroll
        for (int ai = 0; ai < 2; ++ai)
#pragma unroll
            for (int m = 0; m < 4; ++m) {
                const size_t off = (size_t)(row0 + ai * 128 + m * 16) * DM + col0;
#pragma unroll
                for (int bj = 0; bj < 2; ++bj)
#pragma unroll
                    for (int n = 0; n < 2; ++n) {
                        const f32x4 bs = *(const f32x4*)(base + off + bj * 128 + n * 16);
                        *(f32x4*)(out + off + bj * 128 + n * 16) = bs + gv[bj][n] * acc[ai][bj][m][n];
                    }
                asm volatile("" ::: "memory");
            }
    }
};
struct EpiResNext {
    static constexpr bool PERM = true, AFTER_DRAIN = false;
    const float* base; float* out; const float* gate; bf16_t* hu; const float* gnext; const float* scnext; float* rss;
    __device__ __forceinline__ void operator()(const f32x4 (&acc)[2][2][4][2], const pg8::Unit& u, int wr, int wc, int fr, int fq) const {
        const int row0 = u.pm * 256 + wr * 64 + fr, col0 = u.pn * 256 + wc * 32 + 8 * fq, b = u.pm >> 6;
        float ss[8];
#pragma unroll
        for (int i = 0; i < 8; ++i) ss[i] = 0.f;
#pragma unroll
        for (int bj = 0; bj < 2; ++bj) {
            const int col = col0 + bj * 128;
            const f32x4 gv0 = *(const f32x4*)(gate + (size_t)b * 6144 + col), gv1 = *(const f32x4*)(gate + (size_t)b * 6144 + col + 4);
#pragma unroll
            for (int ai = 0; ai < 2; ++ai)
#pragma unroll
                for (int m = 0; m < 4; ++m) {
                    const size_t off = (size_t)(row0 + ai * 128 + m * 16) * DM + col;
                    const f32x4 x0 = *(const f32x4*)(base + off) + gv0 * acc[ai][bj][m][0];
                    const f32x4 x1 = *(const f32x4*)(base + off + 4) + gv1 * acc[ai][bj][m][1];
                    *(f32x4*)(out + off) = x0; *(f32x4*)(out + off + 4) = x1;
                    ss[ai * 4 + m] += ((x0[0] * x0[0] + x0[1] * x0[1]) + (x0[2] * x0[2] + x0[3] * x0[3])) + ((x1[0] * x1[0] + x1[1] * x1[1]) + (x1[2] * x1[2] + x1[3] * x1[3]));
                    const f32x4 cf0 = *(const f32x4*)(gnext + col) * (1.0f + *(const f32x4*)(scnext + (size_t)b * 6144 + col));
                    const f32x4 cf1 = *(const f32x4*)(gnext + col + 4) * (1.0f + *(const f32x4*)(scnext + (size_t)b * 6144 + col + 4));
                    *(bf16x8*)(hu + off) = pack8(x0 * cf0, x1 * cf1);
                    if (m & 1) asm volatile("" ::: "memory");
                }
        }
#pragma unroll
        for (int i = 0; i < 8; ++i) {
            float v = ss[i]; v += __shfl_xor(v, 16); v += __shfl_xor(v, 32);
            if (fq == 0) (void)__hip_atomic_fetch_add(rss + row0 + (i >> 2) * 128 + (i & 3) * 16, v, __ATOMIC_RELAXED, __HIP_MEMORY_SCOPE_AGENT);
        }
    }
};
struct EpiBNorm {
    static constexpr bool PERM = true, AFTER_DRAIN = false;
    bf16_t* O; int ldc; const float* rss; const float* bias;
    __device__ __forceinline__ void operator()(const f32x4 (&acc)[2][2][4][2], const pg8::Unit& u, int wr, int wc, int fr, int fq) const {
        const int row0 = u.pm * 256 + wr * 64 + fr, col0 = u.pn * 256 + wc * 32 + 8 * fq;
        const float* bp = bias + (size_t)(u.pm >> 6) * ldc + col0;
        f32x4 bv[2][2];
#pragma unroll
        for (int bj = 0; bj < 2; ++bj)
#pragma unroll
            for (int n = 0; n < 2; ++n) bv[bj][n] = *(const f32x4*)(bp + bj * 128 + 4 * n);
#pragma unroll
        for (int ai = 0; ai < 2; ++ai)
#pragma unroll
            for (int m = 0; m < 4; ++m) {
                const int row = row0 + ai * 128 + m * 16;
                const float rs = rsqrtf(rss[row] * (1.0f / 2048.0f) + 1e-6f);
                bf16_t* rowp = O + (size_t)row * ldc + col0;
#pragma unroll
                for (int bj = 0; bj < 2; ++bj) {
                    const f32x4 v0 = acc[ai][bj][m][0] * rs + bv[bj][0], v1 = acc[ai][bj][m][1] * rs + bv[bj][1];
                    u32x4 w; w.x = cvt_pk_bf16(v0[0], v0[1]); w.y = cvt_pk_bf16(v0[2], v0[3]); w.z = cvt_pk_bf16(v1[0], v1[1]); w.w = cvt_pk_bf16(v1[2], v1[3]);
                    *(u32x4*)(rowp + bj * 128) = w;
                }
            }
    }
};
struct EpiGateB {
    static constexpr bool PERM = true, AFTER_DRAIN = false;
    bf16_t* O; const float* gate;
    __device__ __forceinline__ void operator()(const f32x4 (&acc)[2][2][4][2], const pg8::Unit& u, int wr, int wc, int fr, int fq) const {
        const int row0 = u.pm * 256 + wr * 64 + fr, col0 = u.pn * 256 + wc * 32 + 8 * fq;
        const float* gp = gate + (size_t)(u.pm >> 6) * 6144 + col0;
        f32x4 gv[2][2];
#pragma unroll
        for (int bj = 0; bj < 2; ++bj)
#pragma unroll
            for (int n = 0; n < 2; ++n) gv[bj][n] = *(const f32x4*)(gp + bj * 128 + 4 * n);
#pragma unroll
        for (int ai = 0; ai < 2; ++ai)
#pragma unroll
            for (int m = 0; m < 4; ++m) {
                bf16_t* rowp = O + (size_t)(row0 + ai * 128 + m * 16) * DM + col0;
#pragma unroll
                for (int bj = 0; bj < 2; ++bj) *(bf16x8*)(rowp + bj * 128) = pack8(acc[ai][bj][m][0] * gv[bj][0], acc[ai][bj][m][1] * gv[bj][1]);
            }
    }
};
struct OneUnit {
    int has; pg8::Unit u;
    __device__ bool next(int i, pg8::Unit& o) const { if (i > 0 || !has) return false; o = u; return true; }
    __device__ __forceinline__ void a_ready(const pg8::Unit&) const {}
    __device__ __forceinline__ void done(const pg8::Unit&) const {}
};

__device__ __forceinline__ void transpose_tile(const float* W, int ldw, int k0, int n0, bf16_t* Wt, int ldt, int nd0, bool ropeperm, LAS bf16_t* tt) {
    const int tid = threadIdx.x;
#pragma unroll
    for (int it = 0; it < 8; ++it) {
        const int idx = it * 512 + tid, kk = idx >> 5, n4 = (idx & 31) * 4;
        const f32x4 v = *(const f32x4*)(W + (size_t)(k0 + kk) * ldw + n0 + n4);
#pragma unroll
        for (int e = 0; e < 4; ++e) {
            int nn = n4 + e;
            if (ropeperm) { const int hs = (nn >> 5) & 1, t = (nn & 31) + ((nn >> 6) << 5); nn = 2 * t + hs; }
            tt[nn * 132 + kk] = f2bf(v[e]);
        }
    }
    __syncthreads();
#pragma unroll
    for (int it = 0; it < 8; ++it) {
        const int idx = it * 512 + tid, nn = idx >> 5, ch = idx & 31;
        const u32x2 w = *(const LAS u32x2*)(tt + nn * 132 + ch * 4);
        *(u32x2*)(Wt + (size_t)(nd0 + nn) * ldt + k0 + ch * 4) = w;
    }
    __syncthreads();
}

__device__ void phase0(const Params& p, LAS unsigned char* lds) {
    const int tid = threadIdx.x;
    LAS float* sc = (LAS float*)lds;
    LAS float* red = (LAS float*)(lds + 24576);
    LAS float* trig = (LAS float*)(lds + 49152);
    LAS bf16_t* tt = (LAS bf16_t*)(lds + 53248);
    unsigned char* ws = p.ws;
    for (int i = tid; i < 3 * DM; i += 512) { const int r = i >> 11, k = i & 2047; const float v = r < 2 ? p.c[r * DM + k] : p.c_ctx[k]; sc[i] = silu(v); }
    if (tid < 128) { float s, c; sincospif((float)tid * (1.0f / 64.0f), &s, &c); trig[tid] = c; trig[128 + tid] = s; }
    __syncthreads();
    constexpr int J0 = 192, J1 = J0 + 640, J2 = J1 + 256, J3 = J2 + 256, J4 = J3 + 256, J5 = J4 + 64, J6 = J5 + 256, J7 = J6 + 20, J8 = J7 + 64, J9 = J8 + 128, J10 = J9 + 256, J11 = J10 + 64;
    for (int job = blockIdx.x; job < J11; job += gridDim.x) {
        if (job < J0) {
            const int L = job / 96, cc = job % 96;
            const float* wm = L ? p.l1_w_mod : p.l0_w_mod; const float* bm = L ? p.l1_b_mod : p.l0_b_mod;
            const int sub = tid & 15, rg = tid >> 4, col = cc * 64 + sub * 4;
            f32x4 a0 = {0.f, 0.f, 0.f, 0.f}, a1 = a0, a2 = a0;
            const float* wp = wm + (size_t)(rg * 64) * 6144 + col;
#pragma unroll 8
            for (int i = 0; i < 64; ++i) {
                const f32x4 w = *(const f32x4*)(wp + (size_t)i * 6144);
                const int k = rg * 64 + i;
                a0 += sc[k] * w; a1 += sc[2048 + k] * w; a2 += sc[4096 + k] * w;
            }
#pragma unroll
            for (int e = 0; e < 4; ++e) { red[(rg * 3 + 0) * 64 + sub * 4 + e] = a0[e]; red[(rg * 3 + 1) * 64 + sub * 4 + e] = a1[e]; red[(rg * 3 + 2) * 64 + sub * 4 + e] = a2[e]; }
            __syncthreads();
            if (tid < 192) {
                const int r = tid >> 6, cl = tid & 63; float s = bm[cc * 64 + cl];
                for (int g = 0; g < 32; ++g) s += red[(g * 3 + r) * 64 + cl];
                ((float*)(ws + WS_MOD))[(size_t)(L * 3 + r) * 6144 + cc * 64 + cl] = s;
            }
            __syncthreads();
        } else if (job < J1) {
            const int j = job - J0, nt = j % 40, kt = j / 40;
            transpose_tile(p.l0_w_in, 5120, kt * 128, nt * 128, (bf16_t*)(ws + WS_WTIN0), 2048, nt * 128, nt < 16, tt);
        } else if (job < J2) {
            const int j = job - J1, nt = j & 15, kt = j >> 4;
            transpose_tile(p.l0_w_out, 2048, kt * 128, nt * 128, (bf16_t*)(ws + WS_WTOUT0), 2048, nt * 128, false, tt);
        } else if (job < J3) {
            const int j = job - J2, nt = j & 15, kt = j >> 4;
            transpose_tile(p.l1_w_in, 4096, kt * 128, 2048 + nt * 128, (bf16_t*)(ws + WS_WTIN1), 2048, 2048 + nt * 128, false, tt);
        } else if (job < J4) {
            const int j = job - J3, nt = j & 15, kt = j >> 4;
            transpose_tile(p.l1_w_out, 2048, kt * 128, nt * 128, (bf16_t*)(ws + WS_WTOUT1), 2048, nt * 128, false, tt);
        } else if (job < J5) {
            const int j = job - J4, g = j >> 4, nt = j & 3, kt = (j >> 2) & 3;
            transpose_tile(p.l1_w_grp + (size_t)g * 262144, 512, kt * 128, nt * 128, (bf16_t*)(ws + WS_WGRPT) + (size_t)g * 262144, 512, nt * 128, false, tt);
        } else if (job < J6) {
            const int j = job - J5;
#pragma unroll
            for (int q = 0; q < 4; ++q) {
                const int e = (q * 512 + tid) * 8, row = j * 8 + (e >> 11), col = e & 2047;
                const float* sp = p.l1_w_in + (size_t)row * 4096 + col;
                const f32x4 v0 = *(const f32x4*)sp, v1 = *(const f32x4*)(sp + 4);
                *(bf16x8*)((bf16_t*)(ws + WS_WBF1) + (size_t)row * 2048 + col) = pack8(v0, v1);
            }
        } else if (job < J7) {
            const int e = (job - J6) * 512 + tid, pos = e >> 5, t = e & 31;
            const float pv = (float)(pos < 256 ? pos : pos - 256);
            const float inv = exp2f(-(float)t * (13.287712379549449f / 32.0f));
            float xr = pv * inv * 0.3183098861837907f;
            xr = xr - 2.0f * rintf(xr * 0.5f);
            float s, c; sincospif(xr, &s, &c);
            ((f32x2*)(ws + WS_ROPE))[e] = (f32x2){c, s};
        } else if (job < J8) {
            const int e = (job - J7) * 512 + tid, row = e >> 7, n1 = e & 127, kind = row >> 7, k1 = row & 127, ix = (k1 * n1) & 127;
            ((bf16_t*)(ws + WS_DC))[e] = f2bf(kind ? -trig[128 + ix] : trig[ix]);
        } else if (job < J9) {
            const int e = (job - J8) * 512 + tid, row = e >> 8, col = e & 255, kp = row >> 7, k2 = row & 127, kd = col >> 7, n2 = col & 127, ix = (k2 * n2) & 127;
            const float c = trig[ix], s = trig[128 + ix];
            ((bf16_t*)(ws + WS_EC))[e] = f2bf(kp == 0 ? (kd == 0 ? c : s) : (kd == 0 ? -s : c));
        } else if (job >= J10) {
            ((float*)(ws + WS_RSS))[(job - J10) * 512 + tid] = 0.f;
        } else {
            const int e = (job - J9) * 512 + tid, kc = e & 255, dp = (e >> 8) & 127, g = e >> 15, kind = kc >> 7;
            const int c = 32 * ((kc >> 5) & 3) + 16 * ((kc >> 2) & 1) + 4 * ((kc >> 3) & 3) + (kc & 3);
            const float* wf = p.l0_w_f + (size_t)g * 16384 + dp; float s = 0.f;
            for (int m = 0; m < 128; ++m) s += trig[kind * 128 + ((m * c) & 127)] * wf[m * 128];
            ((bf16_t*)(ws + WS_MGT))[(size_t)(g * 128 + dp) * 256 + kc] = f2bf(s * 6.905339660024878e-4f);
        }
    }
}

__device__ __forceinline__ void row_load8(const float* s, int lane, f32x4 (&v)[8]) {
#pragma unroll
    for (int j = 0; j < 8; ++j) v[j] = __builtin_nontemporal_load(((const f32x4*)s) + lane + 64 * j);
}
__device__ __forceinline__ float row_rstd(const f32x4 (&v)[8]) {
    float ss = 0.f;
#pragma unroll
    for (int j = 0; j < 8; ++j) ss += (v[j][0] * v[j][0] + v[j][1] * v[j][1]) + (v[j][2] * v[j][2] + v[j][3] * v[j][3]);
#pragma unroll
    for (int o = 32; o >= 1; o >>= 1) ss += __shfl_xor(ss, o);
    return rsqrtf(ss * (1.0f / 2048.0f) + 1e-6f);
}
struct NormArgs { const float* src; bf16_t* dst; const float* gamma; const float* modL; const float* ctx; bf16_t* hc; };
__device__ __forceinline__ const float* nm_src(const NormArgs& a, int r) { return r < MTOK ? a.src + (size_t)r * DM : a.ctx + (size_t)(r - MTOK) * DM; }
__device__ __forceinline__ void nm_finish(const NormArgs& a, int r, int lane, const f32x4 (&v)[8]) {
    bf16_t* d = r < MTOK ? a.dst + (size_t)r * DM : a.hc + (size_t)(r - MTOK) * DM;
    const float* mr = a.modL + (r < MTOK ? (r >> 14) : 2) * 6144;
    const float rs = row_rstd(v);
#pragma unroll
    for (int j = 0; j < 8; ++j) {
        const int c4 = lane + 64 * j;
        const f32x4 g = ((const f32x4*)a.gamma)[c4], sh = ((const f32x4*)mr)[c4], scl = ((const f32x4*)mr)[512 + c4];
        const f32x4 y = (v[j] * rs) * g * (1.0f + scl) + sh;
        *(u32x2*)(d + 4 * c4) = pack4(y);
    }
}
__device__ void norm_mod_phase(const float* src, bf16_t* dst, const float* gamma, const float* modL, const float* ctx, bf16_t* hc) {
    const int lane = threadIdx.x & 63, gw = blockIdx.x * 8 + (threadIdx.x >> 6), nw = gridDim.x * 8;
    const int total = ctx ? MTOK + 512 : MTOK;
    const NormArgs a{src, dst, gamma, modL, ctx, hc};
#ifdef REP_NORM
    for (int rep = 1; rep < REP_NORM; ++rep) { f32x4 vt[8]; for (int rr = gw; rr < total; rr += nw) { row_load8(nm_src(a, rr), lane, vt); nm_finish(a, rr, lane, vt); } }
#endif
    f32x4 va[8], vb[8];
    int r = gw;
    if (r < total) row_load8(nm_src(a, r), lane, va);
    while (r < total) {
        const int r2 = r + nw;
        if (r2 < total) row_load8(nm_src(a, r2), lane, vb);
        nm_finish(a, r, lane, va);
        if (r2 >= total) break;
        const int r3 = r2 + nw;
        if (r3 < total) row_load8(nm_src(a, r3), lane, va);
        nm_finish(a, r2, lane, vb);
        r = r3;
    }
}
__device__ __forceinline__ void fn_finish(float* io, const bf16_t* delta, const float* gamma, int r, int lane, f32x4 (&v)[8], const u32x2 (&dv)[8]) {
    f32x4* s = (f32x4*)(io + (size_t)r * DM);
#pragma unroll
    for (int j = 0; j < 8; ++j) v[j] += unpack4(dv[j]);
    const float rs = row_rstd(v);
#pragma unroll
    for (int j = 0; j < 8; ++j) __builtin_nontemporal_store((v[j] * rs) * ((const f32x4*)gamma)[lane + 64 * j], s + lane + 64 * j);
}
__device__ __forceinline__ void drow_load8(const bf16_t* s, int lane, u32x2 (&v)[8]) {
#pragma unroll
    for (int j = 0; j < 8; ++j) v[j] = ((const u32x2*)s)[lane + 64 * j];
}
__device__ void final_norm_phase(float* io, const bf16_t* delta, const float* gamma) {
    const int lane = threadIdx.x & 63, gw = blockIdx.x * 8 + (threadIdx.x >> 6), nw = gridDim.x * 8;
    f32x4 va[8], vb[8]; u32x2 da[8], db[8];
    int r = gw;
    if (r < MTOK) { row_load8(io + (size_t)r * DM, lane, va); drow_load8(delta + (size_t)r * DM, lane, da); }
    while (r < MTOK) {
        const int r2 = r + nw;
        if (r2 < MTOK) { row_load8(io + (size_t)r2 * DM, lane, vb); drow_load8(delta + (size_t)r2 * DM, lane, db); }
        fn_finish(io, delta, gamma, r, lane, va, da);
        if (r2 >= MTOK) break;
        const int r3 = r2 + nw;
        if (r3 < MTOK) { row_load8(io + (size_t)r3 * DM, lane, va); drow_load8(delta + (size_t)r3 * DM, lane, da); }
        fn_finish(io, delta, gamma, r2, lane, vb, db);
        r = r3;
    }
}

__device__ void bias1_phase(const bf16_t* Wt, const float* mod1, float* bias) {
    const int lane = threadIdx.x & 63, gw = blockIdx.x * 8 + (threadIdx.x >> 6), nw = gridDim.x * 8;
    for (int col = gw; col < 4096; col += nw) {
        float s0 = 0.f, s1 = 0.f;
#pragma unroll
        for (int j = 0; j < 4; ++j) {
            const int k = (j * 64 + lane) * 8;
            const u32x4 wv = *(const u32x4*)(Wt + (size_t)col * 2048 + k);
            const float w8[8] = {bflo(wv.x), bfhi(wv.x), bflo(wv.y), bfhi(wv.y), bflo(wv.z), bfhi(wv.z), bflo(wv.w), bfhi(wv.w)};
            const f32x4 a0 = *(const f32x4*)(mod1 + k), a1 = *(const f32x4*)(mod1 + k + 4), b0 = *(const f32x4*)(mod1 + 6144 + k), b1 = *(const f32x4*)(mod1 + 6144 + k + 4);
            s0 += w8[0] * a0[0] + w8[1] * a0[1] + w8[2] * a0[2] + w8[3] * a0[3] + w8[4] * a1[0] + w8[5] * a1[1] + w8[6] * a1[2] + w8[7] * a1[3];
            s1 += w8[0] * b0[0] + w8[1] * b0[1] + w8[2] * b0[2] + w8[3] * b0[3] + w8[4] * b1[0] + w8[5] * b1[1] + w8[6] * b1[2] + w8[7] * b1[3];
        }
#pragma unroll
        for (int o = 32; o >= 1; o >>= 1) { s0 += __shfl_xor(s0, o); s1 += __shfl_xor(s1, o); }
        if (lane == 0) { bias[col] = s0; bias[4096 + col] = s1; }
    }
}

__device__ void fourier_a_phase(const bf16_t* qkv, const bf16_t* Dc, bf16_t* Y, LAS unsigned char* lds) {
    const int tid = threadIdx.x, lane = tid & 63, w = __builtin_amdgcn_readfirstlane(tid >> 6), g = lane >> 4, li = lane & 15, qq = li >> 2, pp = li & 3;
    const int k1 = 16 * w + li;
    bf16x8 db[2][4];
#pragma unroll
    for (int kd = 0; kd < 2; ++kd)
#pragma unroll
        for (int ks = 0; ks < 4; ++ks) db[kd][ks] = *(const bf16x8*)(Dc + (size_t)(kd * 128 + k1) * 128 + 32 * ks + 8 * g);
    const int fa_first = (gridDim.x > 64) ? (int)blockIdx.x - 8 : (int)blockIdx.x, fa_step = (gridDim.x > 64) ? (int)gridDim.x - 8 : (int)gridDim.x;
    for (int job0 = (fa_first < 0) ? 512 * REP_FA : fa_first; job0 < 512 * REP_FA; job0 += fa_step) {
        const int job = job0 & 511;
        const int chalf = job & 1, n2 = (job >> 1) & 127, b = job >> 8;
#pragma unroll
        for (int it = 0; it < 8; ++it) {
            const int idx = it * 512 + tid, r = idx >> 5, ch = idx & 31;
            const u32x4 v = *(const u32x4*)(qkv + ((size_t)b * SEQ + 128 * r + n2) * LDQ + OFF_F + 256 * chalf + ch * 8);
            *(LAS u32x4*)(lds + r * 528 + ch * 16) = v;
        }
        __syncthreads();
        float sn, cs; sincospif((float)((n2 * k1) & 16383) * (1.0f / 8192.0f), &sn, &cs);
        LAS unsigned char* fb = lds + (8 * g + qq) * 528 + 16 * pp;
        for (int c2 = 0; c2 < 2; ++c2) {
            f32x4 acc[8][2];
#pragma unroll
            for (int ct = 0; ct < 8; ++ct) { acc[ct][0] = (f32x4){0.f, 0.f, 0.f, 0.f}; acc[ct][1] = acc[ct][0]; }
#pragma unroll
            for (int ks = 0; ks < 4; ++ks)
#pragma unroll
                for (int ct = 0; ct < 8; ++ct) {
                    LAS unsigned char* a = fb + ks * 32 * 528 + (128 * c2 + 32 * (ct >> 1) + 4 * (ct & 1)) * 2;
                    const bf16x8 af = tr2(a, a + 4 * 528);
                    acc[ct][0] = mfma16(af, db[0][ks], acc[ct][0]);
                    acc[ct][1] = mfma16(af, db[1][ks], acc[ct][1]);
                }
            bf16_t* yr = Y + ((((size_t)b * 128 + k1) * 2 + 0) * 128 + n2) * 512 + 256 * chalf + 128 * c2 + 8 * g;
            bf16_t* yi = yr + (size_t)128 * 512;
#pragma unroll
            for (int k = 0; k < 4; ++k) {
                const f32x4 a0 = acc[2 * k][0], b0 = acc[2 * k][1], a1 = acc[2 * k + 1][0], b1 = acc[2 * k + 1][1];
                *(bf16x8*)(yr + 32 * k) = pack8(a0 * cs + b0 * sn, a1 * cs + b1 * sn);
                *(bf16x8*)(yi + 32 * k) = pack8(b0 * cs - a0 * sn, b1 * cs - a1 * sn);
            }
        }
        __syncthreads();
    }
}
__device__ void fourier_b_phase(const bf16_t* Y, const bf16_t* Ec, const bf16_t* MgT, const bf16_t* qkv, bf16_t* A0, LAS unsigned char* lds) {
    const int tid = threadIdx.x, lane = tid & 63, w = __builtin_amdgcn_readfirstlane(tid >> 6), g = lane >> 4, li = lane & 15, qq = li >> 2, pp = li & 3;
    const bool mlds = (gridDim.x & 3) == 0;
    LAS unsigned char* ms = lds + 69632;
    if (mlds) {
#pragma unroll
        for (int it = 0; it < 8; ++it) {
            const int idx = it * 512 + tid, r = idx >> 5, ch = idx & 31;
            *(LAS u32x4*)(ms + r * 528 + ch * 16) = *(const u32x4*)(MgT + (size_t)((blockIdx.x & 3) * 128 + r) * 256 + ch * 8);
        }
    }
    for (int job0 = blockIdx.x; job0 < 1024 * REP_FB; job0 += gridDim.x) {
        const int job = job0 & 1023;
        const int grp = job & 3, k1 = (job >> 2) & 127, b = job >> 9;
#pragma unroll
        for (int it = 0; it < 8; ++it) {
            const int idx = it * 512 + tid, r = idx >> 4, ch = idx & 15;
            const u32x4 v = *(const u32x4*)(Y + (((size_t)b * 128 + k1) * 256 + r) * 512 + 128 * grp + ch * 8);
            *(LAS u32x4*)(lds + r * 272 + ch * 16) = v;
        }
        __syncthreads();
        const int k2 = 16 * w + li;
        f32x4 acc[8][2];
#pragma unroll
        for (int ct = 0; ct < 8; ++ct) { acc[ct][0] = (f32x4){0.f, 0.f, 0.f, 0.f}; acc[ct][1] = acc[ct][0]; }
        LAS unsigned char* yb = lds + (8 * g + qq) * 272 + 8 * pp;
        const bf16_t* e0 = Ec + (size_t)k2 * 256 + 8 * g;
#pragma unroll 2
        for (int ks = 0; ks < 8; ++ks) {
            const bf16x8 eb0 = *(const bf16x8*)(e0 + 32 * ks), eb1 = *(const bf16x8*)(e0 + 128 * 256 + 32 * ks);
#pragma unroll
            for (int ct = 0; ct < 8; ++ct) {
                LAS unsigned char* a = yb + ks * 32 * 272 + 32 * ct;
                const bf16x8 af = tr2(a, a + 4 * 272);
                acc[ct][0] = mfma16(af, eb0, acc[ct][0]);
                acc[ct][1] = mfma16(af, eb1, acc[ct][1]);
            }
        }
        f32x4 o2[8];
#pragma unroll
        for (int dt = 0; dt < 8; ++dt) o2[dt] = (f32x4){0.f, 0.f, 0.f, 0.f};
        const bf16_t* mg = MgT + (size_t)(grp * 128 + 8 * (li >> 2) + (li & 3)) * 256 + 8 * g;
#pragma unroll
        for (int kp = 0; kp < 2; ++kp)
#pragma unroll
            for (int ks = 0; ks < 4; ++ks) {
                const bf16x8 bfr = pack8(acc[2 * ks][kp], acc[2 * ks + 1][kp]);
#pragma unroll
                for (int dt = 0; dt < 8; ++dt) {
                    const bf16x8 af = mlds ? *(const LAS bf16x8*)(ms + (8 * (li >> 2) + (li & 3) + 32 * (dt >> 1) + 4 * (dt & 1)) * 528 + (kp * 4 + ks) * 64 + 16 * g)
                                           : *(const bf16x8*)(mg + (size_t)(32 * (dt >> 1) + 4 * (dt & 1)) * 256 + (kp * 4 + ks) * 32);
                    o2[dt] = mfma16(af, bfr, o2[dt]);
                }
            }
        const size_t row = (size_t)b * SEQ + k1 + 128 * k2;
        const bf16_t* zp = qkv + row * LDQ + OFF_Z + 1536 + grp * 128 + 8 * g;
        bf16_t* op = A0 + row * DM + 1536 + grp * 128 + 8 * g;
#pragma unroll
        for (int k = 0; k < 4; ++k) {
            const u32x4 zv = *(const u32x4*)(zp + 32 * k);
            const f32x4 z0 = unpack4((u32x2){zv.x, zv.y}), z1 = unpack4((u32x2){zv.z, zv.w});
            *(bf16x8*)(op + 32 * k) = pack8(o2[2 * k] * silu4(z0), o2[2 * k + 1] * silu4(z1));
        }
        __syncthreads();
    }
}

__device__ void attn_phase(const bf16_t* qkv, const bf16_t* kcvc, const float* sink, bf16_t* A0, LAS unsigned char* lds) {
    const int tid = threadIdx.x, lane = tid & 63, w = __builtin_amdgcn_readfirstlane(tid >> 6), g = lane >> 4, li = lane & 15, qq = li >> 2, pp = li & 3;
    const int sr = tid >> 2, sc4 = tid & 3;
    const int vcu = (gridDim.x & 7) == 0 ? (int)(blockIdx.x & 7) * (int)(gridDim.x >> 3) + (int)(blockIdx.x >> 3) : (int)blockIdx.x;
    const int per = (1536 * REP_ATT + (int)gridDim.x - 1) / (int)gridDim.x;
    const int it_end = min((vcu + 1) * per, 1536 * REP_ATT);
    for (int it0 = vcu * per; it0 < it_end; ++it0) {
        const int it = it0 % 1536;
        const int h = it % 12, np = (it / 12) & 63, b = it / 768, kvh = h / 3;
        const size_t rowbase = (size_t)b * SEQ + np * 256 + 32 * w;
        bf16x8 qf[2][4]; float mrun[2], lrun[2]; f32x4 o[2][8];
        const float sk = sink[h] * LOG2E;
#pragma unroll
        for (int qt = 0; qt < 2; ++qt) {
            const bf16_t* qp = qkv + (rowbase + 16 * qt + li) * LDQ + h * 128 + 8 * g;
#pragma unroll
            for (int ks = 0; ks < 4; ++ks) qf[qt][ks] = *(const bf16x8*)(qp + 32 * ks);
            mrun[qt] = sk; lrun[qt] = (g == 0) ? 1.0f : 0.0f;
#pragma unroll
            for (int dt = 0; dt < 8; ++dt) o[qt][dt] = (f32x4){0.f, 0.f, 0.f, 0.f};
        }
        const int wstart = (np == 0) ? 1 : 0, wend = (np == 63) ? 3 : 4, cnt = 2 + (wend - wstart);
        u32x4 kr[4], vr[4];
#define ATT_LOAD(j) do { const bf16_t* kp_; \
            if ((j) < 2) kp_ = kcvc + ((size_t)b * 256 + 128 * (j) + sr) * 1024 + kvh * 128; \
            else kp_ = qkv + ((size_t)b * SEQ + np * 256 - 128 + ((j) - 2 + wstart) * 128 + sr) * LDQ + OFF_K + kvh * 128; \
            _Pragma("unroll") for (int i_ = 0; i_ < 4; ++i_) { kr[i_] = *(const u32x4*)(kp_ + (sc4 + 4 * i_) * 8); vr[i_] = *(const u32x4*)(kp_ + 512 + (sc4 + 4 * i_) * 8); } } while (0)
#define ATT_STORE(buf) do { LAS unsigned char* kd_ = lds + (buf) * 34816 + sr * 272 + sc4 * 16; LAS unsigned char* vd_ = lds + 69632 + (buf) * 36864 + sr * 288 + sc4 * 16; \
            _Pragma("unroll") for (int i_ = 0; i_ < 4; ++i_) { *(LAS u32x4*)(kd_ + 64 * i_) = kr[i_]; *(LAS u32x4*)(vd_ + 64 * i_) = vr[i_]; } } while (0)
        ATT_LOAD(0); ATT_STORE(0);
        __syncthreads();
        for (int j2 = 0; j2 < cnt; ++j2) {
            if (j2 + 1 < cnt) ATT_LOAD(j2 + 1);
#pragma unroll 1
          for (int hf = 0; hf < 2; ++hf) {
            const int tw = 2 * (j2 - 2 + wstart) + hf;
            const int kpos0 = np * 256 - 128 + tw * 64;
            const int q0 = np * 256 + 32 * w;
            const bool active = (j2 < 2) || (kpos0 + 63 >= q0 - 128 && kpos0 <= q0 + 31 + 128);
            if (active) {
                const bool needmask = (j2 >= 2) && !(kpos0 >= q0 + 31 - 128 && kpos0 + 63 <= q0 + 128);
                LAS unsigned char* kb = lds + (j2 & 1) * 34816 + hf * (64 * 272);
                LAS unsigned char* vb = lds + 69632 + (j2 & 1) * 36864 + hf * (64 * 288);
                f32x4 s[2][4];
#pragma unroll
                for (int qt = 0; qt < 2; ++qt)
#pragma unroll
                    for (int kt = 0; kt < 4; ++kt) s[qt][kt] = (f32x4){0.f, 0.f, 0.f, 0.f};
#pragma unroll
                for (int ks = 0; ks < 4; ++ks)
#pragma unroll
                    for (int kt = 0; kt < 4; ++kt) {
                        const bf16x8 kf = *(const LAS bf16x8*)(kb + (16 * kt + li) * 272 + (32 * ks + 8 * g) * 2);
#pragma unroll
                        for (int qt = 0; qt < 2; ++qt) s[qt][kt] = mfma16(kf, qf[qt][ks], s[qt][kt]);
                    }
                bf16x8 pf[2][2];
#pragma unroll
                for (int qt = 0; qt < 2; ++qt) {
                    if (needmask) {
                        const int qpos = np * 256 + 32 * w + 16 * qt + li;
#pragma unroll
                        for (int kt = 0; kt < 4; ++kt)
#pragma unroll
                            for (int r = 0; r < 4; ++r) { const int d = kpos0 + 16 * kt + 4 * g + r - qpos; if (d > 128 || d < -128) s[qt][kt][r] = -INFINITY; }
                    }
                    float mx = s[qt][0][0];
#pragma unroll
                    for (int kt = 0; kt < 4; ++kt)
#pragma unroll
                        for (int r = 0; r < 4; ++r) mx = fmaxf(mx, s[qt][kt][r]);
                    if (__builtin_amdgcn_ballot_w64(mx > mrun[qt] + 8.0f) != 0ull) {
                        mx = fmaxf(mx, __shfl_xor(mx, 16)); mx = fmaxf(mx, __shfl_xor(mx, 32));
                        const bool grow = mx > mrun[qt] + 8.0f;
                        const float mnew = grow ? mx : mrun[qt], alpha = __builtin_amdgcn_exp2f(mrun[qt] - mnew);
                        mrun[qt] = mnew; lrun[qt] *= alpha;
#pragma unroll
                        for (int dt = 0; dt < 8; ++dt) o[qt][dt] *= alpha;
                    }
                    const float mcur = mrun[qt];
                    float ls = 0.f;
#pragma unroll
                    for (int kt = 0; kt < 4; ++kt)
#pragma unroll
                        for (int r = 0; r < 4; ++r) { const float pe = __builtin_amdgcn_exp2f(s[qt][kt][r] - mcur); s[qt][kt][r] = pe; ls += pe; }
                    lrun[qt] += ls;
                    pf[qt][0] = pack8(s[qt][0], s[qt][1]); pf[qt][1] = pack8(s[qt][2], s[qt][3]);
                }
#pragma unroll
                for (int ks2 = 0; ks2 < 2; ++ks2)
#pragma unroll
                    for (int dt = 0; dt < 8; ++dt) {
                        LAS unsigned char* a = vb + (32 * ks2 + 4 * g + qq) * 288 + (32 * (dt >> 1) + 8 * pp + 4 * (dt & 1)) * 2;
                        const bf16x8 vf = tr2(a, a + 16 * 288);
#pragma unroll
                        for (int qt = 0; qt < 2; ++qt) o[qt][dt] = mfma16(vf, pf[qt][ks2], o[qt][dt]);
                    }
            }
          }
            if (j2 + 1 < cnt) ATT_STORE((j2 + 1) & 1);
            __syncthreads();
        }
#undef ATT_LOAD
#undef ATT_STORE
#pragma unroll
        for (int qt = 0; qt < 2; ++qt) {
            float lt = lrun[qt]; lt += __shfl_xor(lt, 16); lt += __shfl_xor(lt, 32);
            const float inv = 1.0f / lt;
            const bf16_t* zp = qkv + (rowbase + 16 * qt + li) * LDQ + OFF_Z + h * 128 + 8 * g;
            bf16_t* op = A0 + (rowbase + 16 * qt + li) * DM + h * 128 + 8 * g;
#pragma unroll
            for (int k = 0; k < 4; ++k) {
                const u32x4 zv = *(const u32x4*)(zp + 32 * k);
                const f32x4 z0 = unpack4((u32x2){zv.x, zv.y}), z1 = unpack4((u32x2){zv.z, zv.w});
                *(bf16x8*)(op + 32 * k) = pack8(o[qt][2 * k] * inv * silu4(z0), o[qt][2 * k + 1] * inv * silu4(z1));
            }
        }
    }
}

__device__ void pool_phase(const bf16_t* uz, const float* lscale, bf16_t* A1) {
    const int tid = threadIdx.x, sub = tid >> 8, colo = (tid & 255) * 8, grp = colo >> 9, half = 1 << grp;
    float ls[8];
#pragma unroll
    for (int e = 0; e < 8; ++e) ls[e] = lscale[colo + e];
    for (int job0 = blockIdx.x; job0 < 512 * REP_POOL; job0 += gridDim.x) {
        const int job = job0 & 511;
        const int b = job >> 8, t0 = (job & 255) * 64 + sub * 32;
        const bf16_t* ub = uz + (size_t)b * SEQ * 4096 + colo;
        float S[8];
#pragma unroll
        for (int e = 0; e < 8; ++e) S[e] = 0.f;
        const int lo0 = max(t0 - half, 0), hi0 = min(t0 + half, SEQ);
        for (int j = lo0; j < hi0; ++j) {
            const u32x4 v = *(const u32x4*)(ub + (size_t)j * 4096);
            S[0] += bflo(v.x); S[1] += bfhi(v.x); S[2] += bflo(v.y); S[3] += bfhi(v.y); S[4] += bflo(v.z); S[5] += bfhi(v.z); S[6] += bflo(v.w); S[7] += bfhi(v.w);
        }
        for (int tc = t0; tc < t0 + 32; tc += 4) {
            u32x4 uv[4], zv[4], ua[4], us[4];
#pragma unroll
            for (int i = 0; i < 4; ++i) {
                const int t = tc + i;
                uv[i] = *(const u32x4*)(ub + (size_t)t * 4096); zv[i] = *(const u32x4*)(ub + (size_t)t * 4096 + 2048);
                ua[i] = (t + half < SEQ) ? *(const u32x4*)(ub + (size_t)(t + half) * 4096) : (u32x4){0u, 0u, 0u, 0u};
                us[i] = (t - half >= 0) ? *(const u32x4*)(ub + (size_t)(t - half) * 4096) : (u32x4){0u, 0u, 0u, 0u};
            }
#pragma unroll
            for (int i = 0; i < 4; ++i) {
                const int t = tc + i;
                const int lo = max(t - half, 0), hi = min(t + half, SEQ);
                const float rc = 1.0f / (float)(hi - lo);
                const float u8[8] = {bflo(uv[i].x), bfhi(uv[i].x), bflo(uv[i].y), bfhi(uv[i].y), bflo(uv[i].z), bfhi(uv[i].z), bflo(uv[i].w), bfhi(uv[i].w)};
                const float z8[8] = {bflo(zv[i].x), bfhi(zv[i].x), bflo(zv[i].y), bfhi(zv[i].y), bflo(zv[i].z), bfhi(zv[i].z), bflo(zv[i].w), bfhi(zv[i].w)};
                float r8[8];
#pragma unroll
                for (int e = 0; e < 8; ++e) r8[e] = (S[e] * rc - u8[e]) * ls[e] * silu(z8[e]);
                u32x4 wv; wv.x = cvt_pk_bf16(r8[0], r8[1]); wv.y = cvt_pk_bf16(r8[2], r8[3]); wv.z = cvt_pk_bf16(r8[4], r8[5]); wv.w = cvt_pk_bf16(r8[6], r8[7]);
                *(u32x4*)(A1 + ((size_t)b * SEQ + t) * DM + colo) = wv;
                S[0] += bflo(ua[i].x) - bflo(us[i].x); S[1] += bfhi(ua[i].x) - bfhi(us[i].x); S[2] += bflo(ua[i].y) - bflo(us[i].y); S[3] += bfhi(ua[i].y) - bfhi(us[i].y);
                S[4] += bflo(ua[i].z) - bflo(us[i].z); S[5] += bfhi(ua[i].z) - bfhi(us[i].z); S[6] += bflo(ua[i].w) - bflo(us[i].w); S[7] += bfhi(ua[i].w) - bfhi(us[i].w);
            }
        }
    }
}

__device__ __forceinline__ void grid_bar(unsigned* cnt, unsigned target) {
    asm volatile("s_waitcnt vmcnt(0)" ::: "memory");
    __syncthreads();
    if (threadIdx.x == 0) {
        __builtin_amdgcn_fence(__ATOMIC_RELEASE, "agent");
        asm volatile("s_waitcnt vmcnt(0)" ::: "memory");
        (void)__hip_atomic_fetch_add(cnt, 1u, __ATOMIC_RELAXED, __HIP_MEMORY_SCOPE_AGENT);
        unsigned sp = 0;
        while (__hip_atomic_load(cnt, __ATOMIC_RELAXED, __HIP_MEMORY_SCOPE_AGENT) < target) { __builtin_amdgcn_s_sleep(1); if (++sp > (1u << 24)) break; }
        __builtin_amdgcn_fence(__ATOMIC_ACQUIRE, "agent");
        asm volatile("s_waitcnt vmcnt(0)" ::: "memory");
    }
    __syncthreads();
}

#define XB_TMO      128
#define XB_XCNT(j)  (256  + 64 * (j))
#define XB_XSUB(j)  (1280 + 64 * (j))
#define XB_XGEN(j)  (2304 + 64 * (j))
#define XB_TOP      3328
#define XB_TOPGEN   3392
#define XB_SPIN_CAP (1u << 22)
__device__ __forceinline__ unsigned xb_ld(unsigned* p)              { return __hip_atomic_load(p, __ATOMIC_RELAXED, __HIP_MEMORY_SCOPE_AGENT); }
__device__ __forceinline__ unsigned xb_add(unsigned* p, unsigned v) { return __hip_atomic_fetch_add(p, v, __ATOMIC_RELAXED, __HIP_MEMORY_SCOPE_AGENT); }
__device__ __forceinline__ unsigned xb_xcc_id() { return (unsigned)__builtin_amdgcn_s_getreg((3 << 11) | 20) & 0xFu; }
#define XB_SPIN(cond, bar) do { unsigned _sp = 0; while (cond) { __builtin_amdgcn_s_sleep(1); \
    if ((++_sp & 255u) == 0u) { if (xb_ld(&(bar)[XB_TMO])) break; if (_sp > XB_SPIN_CAP) { atomicAdd(&(bar)[XB_TMO], 1u); break; } } } } while (0)
struct XcdBar { unsigned* bar; unsigned x, nloc, nx; };
__device__ __forceinline__ void xcd_bar(XcdBar& b) {
    asm volatile("s_waitcnt vmcnt(0)" ::: "memory");
    __syncthreads();
    if (threadIdx.x == 0) {
        unsigned* bar = b.bar;
        __builtin_amdgcn_s_waitcnt(0);
        if (b.nloc == 0u) {
            const unsigned G = gridDim.x; unsigned sum, cnt, mine, sp = 0u;
            for (;;) {
                sum = 0u; cnt = 0u; mine = 0u;
#pragma unroll
                for (unsigned j = 0; j < 16; ++j) { const unsigned c = xb_ld(&bar[XB_XCNT(j)]); sum += c; cnt += (c > 0u) ? 1u : 0u; mine = (j == b.x) ? c : mine; }
                if (sum == G) break;
                __builtin_amdgcn_s_sleep(1);
                if ((++sp & 255u) == 0u) { if (xb_ld(&bar[XB_TMO])) break; if (sp > XB_SPIN_CAP) { atomicAdd(&bar[XB_TMO], 1u); break; } }
            }
            b.nloc = mine > 0u ? mine : 1u; b.nx = cnt > 0u ? cnt : 1u;
        }
        const unsigned nloc = b.nloc, nx = b.nx;
        const unsigned old = xb_add(&bar[XB_XSUB(b.x)], 1u);
        const unsigned gen = old / nloc;
        if (old + 1u == (gen + 1u) * nloc) {
            __builtin_amdgcn_fence(__ATOMIC_RELEASE, "agent");
            asm volatile("s_waitcnt vmcnt(0)" ::: "memory");
            const unsigned og = xb_add(&bar[XB_TOP], 1u);
            const unsigned tg = og / nx;
            if (og + 1u == (tg + 1u) * nx) xb_add(&bar[XB_TOPGEN], 1u);
            else XB_SPIN(xb_ld(&bar[XB_TOPGEN]) == tg, bar);
            __builtin_amdgcn_fence(__ATOMIC_ACQUIRE, "agent");
            xb_add(&bar[XB_XGEN(b.x)], 1u);
            asm volatile("s_waitcnt vmcnt(0)" ::: "memory");
        } else {
            XB_SPIN(xb_ld(&bar[XB_XGEN(b.x)]) == gen, bar);
            __builtin_amdgcn_fence(__ATOMIC_ACQUIRE, "agent");
            asm volatile("s_waitcnt vmcnt(0)" ::: "memory");
        }
    }
    __syncthreads();
}

__global__ void __launch_bounds__(512, 2) fwd_mega(Params p) {
    extern __shared__ __attribute__((aligned(16))) unsigned char lds_raw[];
    LAS unsigned char* lds = (LAS unsigned char*)lds_raw;
    cg::grid_group grid = cg::this_grid();
    unsigned char* ws = p.ws;
    const float* mod = (const float*)(ws + WS_MOD);
    const f32x2* rope = (const f32x2*)(ws + WS_ROPE);
    bf16_t* Dc = (bf16_t*)(ws + WS_DC); bf16_t* Ec = (bf16_t*)(ws + WS_EC); bf16_t* MgT = (bf16_t*)(ws + WS_MGT);
    bf16_t* WtIn0 = (bf16_t*)(ws + WS_WTIN0); bf16_t* WtOut0 = (bf16_t*)(ws + WS_WTOUT0); bf16_t* WtIn1 = (bf16_t*)(ws + WS_WTIN1); bf16_t* WtOut1 = (bf16_t*)(ws + WS_WTOUT1);
    bf16_t* Wbf1 = (bf16_t*)(ws + WS_WBF1); bf16_t* WgrpT = (bf16_t*)(ws + WS_WGRPT);
    bf16_t* H = (bf16_t*)(ws + WS_H); bf16_t* HC = (bf16_t*)(ws + WS_HC); bf16_t* QKV = (bf16_t*)(ws + WS_QKV); bf16_t* KCVC = (bf16_t*)(ws + WS_KCVC);
    bf16_t* Y = (bf16_t*)(ws + WS_Y); bf16_t* AB = (bf16_t*)(ws + WS_A);
    float* RSS = (float*)(ws + WS_RSS); float* BIAS1 = (float*)(ws + WS_BIAS1);
    const int G = gridDim.x, bid = blockIdx.x;

    unsigned* barcnt = (unsigned*)(ws + WS_BAR); unsigned nbar = 0;
    XcdBar xbar; xbar.bar = (unsigned*)(ws + WS_XBAR); xbar.x = xb_xcc_id(); xbar.nloc = 0u; xbar.nx = 0u;
    if (threadIdx.x == 0) (void)xb_add(&xbar.bar[XB_XCNT(xbar.x)], 1u);
#ifdef USE_CG_SYNC
#define GRID_BAR() grid.sync()
#else
#ifdef USE_FLAT_BAR
#define GRID_BAR() do { ++nbar; grid_bar(barcnt, nbar * (unsigned)G); } while (0)
#else
#define GRID_BAR() xcd_bar(xbar)
#endif
#endif
    phase0(p, lds);
#if REP_P0 > 1
    __syncthreads(); phase0(p, lds); __syncthreads(); phase0(p, lds);
#endif
#ifdef USE_CG_SYNC
    grid.sync();
#else
    if (p.ws == nullptr) grid.sync();
    GRID_BAR();
#endif

    norm_mod_phase(p.x, H, p.l0_norm, mod, p.ctx, HC);
    GRID_BAR();

    {
        pg8::Gemm g{H, WtIn0, MTOK, 5120, 2048, 2048, 2048}; pg8::StaticOrder S; S.init(MTOK, 5120, G, bid);
        EpiB<1> E{QKV, LDQ, rope};
        pg8::gemm_phase<EpiB<1>, pg8::StaticOrder, false>(lds, g, S, E, nullptr);
#if REP_G0 > 1
        pg8::gemm_phase<EpiB<1>, pg8::StaticOrder, false>(lds, g, S, E, nullptr);
#endif
    }
    GRID_BAR();

    {
        pg8::Gemm g{HC, WtIn0 + (size_t)OFF_K * 2048, 512, 1024, 2048, 2048, 2048}; pg8::StaticOrder S; S.init(512, 1024, G, bid);
        EpiB<0> E{KCVC, 1024, nullptr};
        pg8::gemm_phase<EpiB<0>, pg8::StaticOrder, false>(lds, g, S, E, nullptr);
    }
    {
        const int fbk = (bid - 8) & 63, grp = fbk >> 4, wi = fbk & 15;
        pg8::Gemm g{WgrpT + (size_t)grp * 262144, Wbf1 + grp * 512, 512, 2048, 512, 512, 2048};
        OneUnit S{(G >= 72 ? (bid >= 8 && bid < 72) : (bid < 64)) ? 1 : 0, {wi >> 3, wi & 7}};
        EpiB<0> E{WtIn1 + (size_t)grp * 512 * 2048, 2048, nullptr};
        pg8::gemm_phase<EpiB<0>, OneUnit, false>(lds, g, S, E, nullptr);
    }
    fourier_a_phase(QKV, Dc, Y, lds);
    GRID_BAR();

    bias1_phase(WtIn1, mod + 3 * 6144, BIAS1);
    attn_phase(QKV, KCVC, p.l0_sink, AB, lds);
#if REP_P4 == 2
    attn_phase(QKV, KCVC, p.l0_sink, AB, lds);
#endif
    fourier_b_phase(Y, Ec, MgT, QKV, AB, lds);
#if REP_P4 == 3
    fourier_b_phase(Y, Ec, MgT, QKV, AB, lds);
#endif
#if REP_P4 == 4
    GRID_BAR();
    attn_phase(QKV, KCVC, p.l0_sink, AB, lds);
#endif
    GRID_BAR();

    {
        pg8::Gemm g{AB, WtOut0, MTOK, 2048, 2048, 2048, 2048}; pg8::StaticOrder S; S.init(MTOK, 2048, G, bid);
        EpiResNext E{p.x, p.out, mod + 4096, H, p.l1_norm, mod + 3 * 6144 + 2048, RSS};
        pg8::gemm_phase<EpiResNext, pg8::StaticOrder, false>(lds, g, S, E, nullptr);
    }
    GRID_BAR();

    {
        pg8::Gemm g{H, WtIn1, MTOK, 4096, 2048, 2048, 2048}; pg8::StaticOrder S; S.init(MTOK, 4096, G, bid);
        EpiBNorm E{QKV, 4096, RSS, BIAS1};
        pg8::gemm_phase<EpiBNorm, pg8::StaticOrder, false>(lds, g, S, E, nullptr);
#if REP_G2 > 1
        pg8::gemm_phase<EpiBNorm, pg8::StaticOrder, false>(lds, g, S, E, nullptr);
#endif
    }
    GRID_BAR();

#if REP_MEM > 1
    pool_phase(QKV, p.l1_scale, AB);
#endif
    pool_phase(QKV, p.l1_scale, AB);
    GRID_BAR();

    {
        pg8::Gemm g{AB, WtOut1, MTOK, 2048, 2048, 2048, 2048}; pg8::StaticOrder S; S.init(MTOK, 2048, G, bid);
        EpiGateB E{H, mod + 3 * 6144 + 4096};
        pg8::gemm_phase<EpiGateB, pg8::StaticOrder, false>(lds, g, S, E, nullptr);
    }
    GRID_BAR();

#ifdef REP_SYNC
    for (int rep = 0; rep < REP_SYNC; ++rep) GRID_BAR();
#endif
    final_norm_phase(p.out, H, p.final_norm);
}

extern "C" void kernel_launch(void* const* d_in, const int* in_sizes, int n_in, void* d_out, int out_size, void* d_ws, size_t ws_size, hipStream_t stream) {
    static int grid_blocks = 0;
    if (!grid_blocks) {
        int dev = 0, cus = 0, per_cu = 0;
        (void)hipGetDevice(&dev);
        (void)hipDeviceGetAttribute(&cus, hipDeviceAttributeMultiprocessorCount, dev);
        (void)hipFuncSetAttribute((const void*)fwd_mega, hipFuncAttributeMaxDynamicSharedMemorySize, LDS_BYTES);
        (void)hipOccupancyMaxActiveBlocksPerMultiprocessor(&per_cu, (const void*)fwd_mega, 512, LDS_BYTES);
        if (per_cu < 1) per_cu = 1;
        grid_blocks = cus * per_cu;
        if (ws_size < WS_END) fprintf(stderr, "kernel_launch: workspace too small (%zu < %zu)\n", ws_size, (size_t)WS_END);
    }
    Params p{};
    p.x = (const float*)d_in[0]; p.c = (const float*)d_in[1]; p.ctx = (const float*)d_in[2]; p.c_ctx = (const float*)d_in[3];
    p.l0_norm = (const float*)d_in[4]; p.l0_w_mod = (const float*)d_in[5]; p.l0_b_mod = (const float*)d_in[6]; p.l0_w_in = (const float*)d_in[7];
    p.l0_sink = (const float*)d_in[8]; p.l0_w_f = (const float*)d_in[9]; p.l0_w_out = (const float*)d_in[10];
    p.l1_norm = (const float*)d_in[11]; p.l1_w_mod = (const float*)d_in[12]; p.l1_b_mod = (const float*)d_in[13]; p.l1_w_in = (const float*)d_in[14];
    p.l1_w_grp = (const float*)d_in[15]; p.l1_scale = (const float*)d_in[16]; p.l1_w_out = (const float*)d_in[17]; p.final_norm = (const float*)d_in[18];
    p.out = (float*)d_out; p.ws = (unsigned char*)d_ws;
#ifndef USE_CG_SYNC
    (void)hipMemsetAsync((char*)d_ws + WS_XBAR, 0, 16384, stream);
#endif
    void* args[] = {&p};
    hipError_t e = hipLaunchCooperativeKernel((void*)fwd_mega, dim3(grid_blocks), dim3(512), args, LDS_BYTES, stream);
    if (e != hipSuccess) fprintf(stderr, "cooperative launch failed: %s (grid %d)\n", hipGetErrorString(e), grid_blocks);
}
```

```cpp
#include <hip/hip_runtime.h>
#include <hip/hip_cooperative_groups.h>
#include <cstdio>
namespace cg = cooperative_groups;

namespace pg8 {
#define PG8_LAS __attribute__((address_space(3)))
typedef unsigned short bf16_t;
typedef short bf16x8 __attribute__((ext_vector_type(8)));
typedef float f32x4 __attribute__((ext_vector_type(4)));
typedef unsigned u32x4 __attribute__((ext_vector_type(4)));
constexpr int BM = 256, BK = 64, HALF = 128, HTB = HALF * BK * 2  , STAGE_BYTES = 8 * HTB, NXCD = 8, WGM = 8;

__host__ __device__ __forceinline__ int lds_byte(int r, int c) { const int st = (r >> 4) * 2 + (c >> 5), rr = r & 15, cc = c & 31, ob = rr * 64 + cc * 2; return st * 1024 + (ob ^ (((ob >> 9) & 1) << 5)); }
__host__ __device__ __forceinline__ void stage_rc(int b, int& R, int& C) { const int st = b / 1024, sb = b % 1024, swz = sb ^ (((sb >> 9) & 1) << 5); R = (st >> 1) * 16 + swz / 64; C = (st & 1) * 32 + (swz % 64) / 2; }
__host__ __device__ __forceinline__ int perm32(int rho) { const int n = rho >> 4, i = rho & 15; return 8 * (i >> 2) + 4 * n + (i & 3); }

struct Unit { int pm, pn; };
struct Gemm { const bf16_t* A; const bf16_t* Bt; int M, N, K, lda, ldb; };

struct StaticOrder {
    int nM, nN, nwg, G, c;
    __host__ __device__ void init(int M, int N, int G_, int c_) { nM = M / BM; nN = N / BM; nwg = nM * nN; G = G_; c = c_; }
    __host__ __device__ bool next(int i, Unit& u) const {
        const long L = (long)i * G + c; if (L >= nwg) return false;
        int wgid = (int)L; { const int q = nwg / NXCD, r = nwg % NXCD, xcd = wgid % NXCD, off = wgid / NXCD; wgid = (xcd < r ? xcd * (q + 1) : r * (q + 1) + (xcd - r) * q) + off; }
        const int nig = WGM * nN, gid = wgid / nig, fm = gid * WGM, gsz = (nM - fm) < WGM ? (nM - fm) : WGM;
        u.pm = fm + ((wgid % nig) % gsz); u.pn = (wgid % nig) / gsz; return true;
    }
    __device__ __forceinline__ void a_ready(const Unit&) const {}
    __device__ __forceinline__ void done(const Unit&) const {}
};
__device__ __forceinline__ unsigned cvt_pk_bf16(float lo, float hi) { unsigned r; asm("v_cvt_pk_bf16_f32 %0, %1, %2" : "=v"(r) : "v"(lo), "v"(hi)); return r; }
template <class Epi, class Sched, bool STAMP = false>
__device__ __forceinline__ void gemm_phase(PG8_LAS unsigned char* lds, const Gemm g, const Sched& S, const Epi& E, unsigned long long* stamps) {
    const int tid = threadIdx.x, wid = __builtin_amdgcn_readfirstlane(tid >> 6), lane = tid & 63, wr = wid >> 2, wc = wid & 3, fr = lane & 15, fq = lane >> 4;
    const int K = g.K, nt = K / BK;
    int ts_lo = 0, ts_hi = 0, nts = 0; const unsigned long long rt_entry = STAMP ? (unsigned long long)wall_clock64() : 0ull;
#define PG8_STAMP() do { if (STAMP && wid == 0 && nts < 64) { const unsigned long long _c = (unsigned long long)clock64(); \
        ts_lo = (lane == nts) ? (int)(unsigned)_c : ts_lo; ts_hi = (lane == nts) ? (int)(unsigned)(_c >> 32) : ts_hi; ++nts; } } while (0)
    PG8_STAMP();
    unsigned voffA[2], voffB[2];
#pragma unroll
    for (int i = 0; i < 2; ++i) { int R, C; stage_rc(tid * 16 + i * 8192, R, C); const int Rb = Epi::PERM ? ((R & ~31) + perm32(R & 31)) : R;
        voffA[i] = (unsigned)(R * g.lda + C) * 2u; voffB[i] = (unsigned)(Rb * g.ldb + C) * 2u; }
    const size_t kstep = (size_t)(BK * 2);
    const size_t hstepA = (size_t)HALF * g.lda * 2, hstepB = (size_t)HALF * g.ldb * 2;
    const size_t tstepA = 2 * hstepA, tstepB = 2 * hstepB;
    const unsigned ldsw = (unsigned)wid * 1024u;
    const int aoff = lds_byte(wr * 64 + fr, fq * 8), boff = lds_byte(wc * 32 + fr, fq * 8);
#define PG8_SA(b, h) (((b) * 2 + (h)) * HTB)
#define PG8_SB(b, h) ((4 + (b) * 2 + (h)) * HTB)
#define PG8_STAGE(bufoff, gbase, voff) do { _Pragma("unroll") for (int _i = 0; _i < 2; ++_i) \
        __builtin_amdgcn_global_load_lds((const unsigned*)((const char*)(gbase) + (voff)[_i]), (PG8_LAS unsigned*)(lds + (bufoff) + ldsw + _i * 8192), 16, 0, 0); } while (0)
#define PG8_LDA(dst, b, h) do { _Pragma("unroll") for (int m = 0; m < 4; ++m) _Pragma("unroll") for (int k = 0; k < 2; ++k) dst[m][k] = *(const PG8_LAS bf16x8*)(lds + PG8_SA(b, h) + aoff + m * 2048 + k * 1024); } while (0)
#define PG8_LDB(dst, b, h) do { _Pragma("unroll") for (int n = 0; n < 2; ++n) _Pragma("unroll") for (int k = 0; k < 2; ++k) dst[n][k] = *(const PG8_LAS bf16x8*)(lds + PG8_SB(b, h) + boff + n * 2048 + k * 1024); } while (0)
#define PG8_MMA(ai, bj, At, Bt) do { __builtin_amdgcn_s_setprio(1); _Pragma("unroll") for (int m = 0; m < 4; ++m) _Pragma("unroll") for (int n = 0; n < 2; ++n) _Pragma("unroll") for (int k = 0; k < 2; ++k) \
        acc[ai][bj][m][n] = __builtin_amdgcn_mfma_f32_16x16x32_bf16(Bt[n][k], At[m][k], acc[ai][bj][m][n], 0, 0, 0); __builtin_amdgcn_s_setprio(0); } while (0)
#define PG8_WAIT_V(n) asm volatile("s_waitcnt vmcnt(" #n ")" ::: "memory")
#define PG8_WAIT_L(n) asm volatile("s_waitcnt lgkmcnt(" #n ")" ::: "memory")
#define PG8_BAR __builtin_amdgcn_s_barrier()
#define PG8_SCHED __builtin_amdgcn_sched_barrier(0)
    Unit cur, nxt; int ui = 0;
    if (!S.next(0, cur)) return;
    f32x4 acc[2][2][4][2];
#pragma unroll
    for (int a = 0; a < 2; ++a)
#pragma unroll
        for (int b = 0; b < 2; ++b)
#pragma unroll
            for (int m = 0; m < 4; ++m)
#pragma unroll
                for (int n = 0; n < 2; ++n) acc[a][b][m][n] = (f32x4){0.f, 0.f, 0.f, 0.f};
    bf16x8 At[4][2], B0[2][2], B1[2][2];
    const char* cA = (const char*)g.A + (size_t)cur.pm * tstepA; const char* cB = (const char*)g.Bt + (size_t)cur.pn * tstepB;
    S.a_ready(cur);
    PG8_STAGE(PG8_SB(0, 0), cB, voffB); PG8_STAGE(PG8_SA(0, 0), cA, voffA); PG8_STAGE(PG8_SB(0, 1), cB + hstepB, voffB); PG8_STAGE(PG8_SA(0, 1), cA + hstepA, voffA);
    if (wr == 1) PG8_BAR;
    PG8_WAIT_V(4); PG8_BAR;
    PG8_STAGE(PG8_SB(1, 0), cB + kstep, voffB); PG8_STAGE(PG8_SA(1, 0), cA + kstep, voffA); PG8_STAGE(PG8_SB(1, 1), cB + hstepB + kstep, voffB);
    PG8_WAIT_V(6); PG8_BAR;
    PG8_STAMP();
    for (;;) {
        const bool has_next = S.next(ui + 1, nxt);
        const char* nA = has_next ? (const char*)g.A + (size_t)nxt.pm * tstepA : cA; const char* nB = has_next ? (const char*)g.Bt + (size_t)nxt.pn * tstepB : cB;
        for (int t = 0; t < nt; t += 2) {
            const bool last = (t == nt - 2);
            const char* a1 = cA + (size_t)(t + 1) * kstep;
            const char* a2 = last ? nA : cA + (size_t)(t + 2) * kstep; const char* b2 = last ? nB : cB + (size_t)(t + 2) * kstep;
            const char* a3 = a2 + kstep; const char* b3 = b2 + kstep;
            if (last && has_next) S.a_ready(nxt);
            PG8_LDB(B0, 0, 0); PG8_SCHED; PG8_LDA(At, 0, 0); PG8_STAGE(PG8_SA(1, 1), a1 + hstepA, voffA);
            PG8_WAIT_L(8); PG8_BAR; PG8_WAIT_L(0); PG8_MMA(0, 0, At, B0); PG8_BAR; PG8_SCHED;
            PG8_LDB(B1, 0, 1); PG8_STAGE(PG8_SB(0, 0), b2, voffB);
            PG8_BAR; PG8_WAIT_L(0); PG8_MMA(0, 1, At, B1); PG8_BAR;
            PG8_LDA(At, 0, 1); PG8_STAGE(PG8_SA(0, 0), a2, voffA);
            PG8_BAR; PG8_WAIT_L(0); PG8_MMA(1, 0, At, B0); PG8_BAR; PG8_SCHED;
            PG8_STAGE(PG8_SB(0, 1), b2 + hstepB, voffB);
            PG8_WAIT_V(6); PG8_BAR; PG8_MMA(1, 1, At, B1); PG8_BAR;
            PG8_LDB(B0, 1, 0); PG8_SCHED; PG8_LDA(At, 1, 0); PG8_STAGE(PG8_SA(0, 1), a2 + hstepA, voffA);
            PG8_WAIT_L(8); PG8_BAR; PG8_WAIT_L(0); PG8_MMA(0, 0, At, B0); PG8_BAR; PG8_SCHED;
            PG8_LDB(B1, 1, 1); PG8_STAGE(PG8_SB(1, 0), b3, voffB);
            PG8_BAR; PG8_WAIT_L(0); PG8_MMA(0, 1, At, B1); PG8_BAR;
            PG8_LDA(At, 1, 1); PG8_STAGE(PG8_SA(1, 0), a3, voffA);
            PG8_BAR; PG8_WAIT_L(0); PG8_MMA(1, 0, At, B0); PG8_BAR; PG8_SCHED;
            PG8_STAGE(PG8_SB(1, 1), b3 + hstepB, voffB);
            PG8_WAIT_V(6); PG8_BAR; PG8_MMA(1, 1, At, B1); PG8_BAR;
        }
        PG8_STAMP();
        if constexpr (!Epi::AFTER_DRAIN) { E(acc, cur, wr, wc, fr, fq); S.done(cur); }
        PG8_STAMP();
        if (!has_next) break;
#pragma unroll
        for (int a = 0; a < 2; ++a)
#pragma unroll
            for (int b = 0; b < 2; ++b)
#pragma unroll
                for (int m = 0; m < 4; ++m)
#pragma unroll
                    for (int n = 0; n < 2; ++n) acc[a][b][m][n] = (f32x4){0.f, 0.f, 0.f, 0.f};
        cur = nxt; cA = nA; cB = nB; ++ui;
    }
    PG8_WAIT_V(0);
    if (wr == 0) PG8_BAR;
    PG8_BAR;
    if constexpr (Epi::AFTER_DRAIN) { E.fused(acc, cur, wr, wc, fr, fq, lds, wid, lane); S.done(cur); }
    PG8_STAMP();
    if (STAMP && wid == 0) { stamps[lane] = lane < nts ? (((unsigned long long)(unsigned)ts_hi << 32) | (unsigned)ts_lo) : 0ull;
        if (lane == 62) stamps[62] = rt_entry; if (lane == 63) stamps[63] = (unsigned long long)wall_clock64(); }
#undef PG8_STAMP
#undef PG8_SA
#undef PG8_SB
#undef PG8_STAGE
#undef PG8_LDA
#undef PG8_LDB
#undef PG8_MMA
#undef PG8_WAIT_V
#undef PG8_WAIT_L
#undef PG8_BAR
#undef PG8_SCHED
}
}

#define LAS __attribute__((address_space(3)))
using pg8::bf16_t; using pg8::bf16x8; using pg8::f32x4; using pg8::u32x4; using pg8::cvt_pk_bf16;
typedef short s16x4 __attribute__((ext_vector_type(4)));
typedef unsigned u32x2 __attribute__((ext_vector_type(2)));
typedef float f32x2 __attribute__((ext_vector_type(2)));

constexpr int DM = 2048, SEQ = 16384, MTOK = 32768;
constexpr int LDQ = 5120;
constexpr int OFF_K = 1536, OFF_V = 2048, OFF_F = 2560, OFF_Z = 3072;
constexpr float LOG2E = 1.4426950408889634f;
constexpr float QSCALE = 0.08838834764831845f * 1.4426950408889634f;
constexpr int LDS_BYTES = 143360;
#ifndef REP_ATT
#define REP_ATT 1
#endif
#ifndef REP_FA
#define REP_FA 1
#endif
#ifndef REP_FB
#define REP_FB 1
#endif
#ifndef REP_POOL
#define REP_POOL 1
#endif
#ifndef REP_P0
#define REP_P0 1
#endif
#ifndef REP_G0
#define REP_G0 1
#endif
#ifndef REP_P4
#define REP_P4 1
#endif
#ifndef REP_G2
#define REP_G2 1
#endif
#ifndef REP_MEM
#define REP_MEM 1
#endif

constexpr size_t WS_BAR = 0;
constexpr size_t WS_MOD = 256;
constexpr size_t WS_ROPE = WS_MOD + 147456;
constexpr size_t WS_DC = WS_ROPE + 81920;
constexpr size_t WS_EC = WS_DC + 65536;
constexpr size_t WS_MGT = WS_EC + 131072;
constexpr size_t WS_WTIN0 = WS_MGT + 262144;
constexpr size_t WS_WTOUT0 = WS_WTIN0 + 20971520;
constexpr size_t WS_WTIN1 = WS_WTOUT0 + 8388608;
constexpr size_t WS_WTOUT1 = WS_WTIN1 + 16777216;
constexpr size_t WS_WBF1 = WS_WTOUT1 + 8388608;
constexpr size_t WS_WGRPT = WS_WBF1 + 8388608;
constexpr size_t WS_H = WS_WGRPT + 2097152;
constexpr size_t WS_HC = WS_H + 134217728;
constexpr size_t WS_QKV = WS_HC + 2097152;
constexpr size_t WS_KCVC = WS_QKV + 335544320;
constexpr size_t WS_Y = WS_KCVC + 1048576;
constexpr size_t WS_A = WS_Y + 67108864;
constexpr size_t WS_RSS = WS_A + 134217728;
constexpr size_t WS_BIAS1 = WS_RSS + 131072;
constexpr size_t WS_XBAR = WS_BIAS1 + 32768;
constexpr size_t WS_END = WS_XBAR + 16384;

struct Params {
    const float *x, *c, *ctx, *c_ctx;
    const float *l0_norm, *l0_w_mod, *l0_b_mod, *l0_w_in, *l0_sink, *l0_w_f, *l0_w_out;
    const float *l1_norm, *l1_w_mod, *l1_b_mod, *l1_w_in, *l1_w_grp, *l1_scale, *l1_w_out, *final_norm;
    float* out; unsigned char* ws;
};

__device__ __forceinline__ float bflo(unsigned u) { return __uint_as_float(u << 16); }
__device__ __forceinline__ float bfhi(unsigned u) { return __uint_as_float(u & 0xffff0000u); }
__device__ __forceinline__ unsigned short f2bf(float f) { return (unsigned short)(cvt_pk_bf16(f, f) & 0xffffu); }
__device__ __forceinline__ float silu(float v) { return v * __builtin_amdgcn_rcpf(1.0f + __expf(-v)); }
__device__ __forceinline__ f32x4 mfma16(bf16x8 a, bf16x8 b, f32x4 c) { return __builtin_amdgcn_mfma_f32_16x16x32_bf16(a, b, c, 0, 0, 0); }
__device__ __forceinline__ bf16x8 tr2(LAS unsigned char* p0, LAS unsigned char* p1) {
    const s16x4 a = __builtin_amdgcn_ds_read_tr16_b64_v4i16((LAS s16x4*)p0);
    const s16x4 b = __builtin_amdgcn_ds_read_tr16_b64_v4i16((LAS s16x4*)p1);
    return __builtin_shufflevector(a, b, 0, 1, 2, 3, 4, 5, 6, 7);
}
__device__ __forceinline__ bf16x8 pack8(f32x4 a, f32x4 b) {
    u32x4 w; w.x = cvt_pk_bf16(a[0], a[1]); w.y = cvt_pk_bf16(a[2], a[3]); w.z = cvt_pk_bf16(b[0], b[1]); w.w = cvt_pk_bf16(b[2], b[3]);
    return __builtin_bit_cast(bf16x8, w);
}
__device__ __forceinline__ u32x2 pack4(f32x4 a) { u32x2 w; w.x = cvt_pk_bf16(a[0], a[1]); w.y = cvt_pk_bf16(a[2], a[3]); return w; }
__device__ __forceinline__ f32x4 unpack4(u32x2 w) { return (f32x4){bflo(w.x), bfhi(w.x), bflo(w.y), bfhi(w.y)}; }
__device__ __forceinline__ f32x4 silu4(f32x4 z) { return (f32x4){silu(z[0]), silu(z[1]), silu(z[2]), silu(z[3])}; }

template <int MODE> struct EpiB {
    static constexpr bool PERM = true, AFTER_DRAIN = false;
    bf16_t* O; int ldc; const f32x2* rope;
    __device__ __forceinline__ void operator()(const f32x4 (&acc)[2][2][4][2], const pg8::Unit& u, int wr, int wc, int fr, int fq) const {
        const int row0 = u.pm * 256 + wr * 64 + fr, col0 = u.pn * 256 + wc * 32 + 8 * fq;
#pragma unroll
        for (int ai = 0; ai < 2; ++ai)
#pragma unroll
            for (int m = 0; m < 4; ++m) {
                const int row = row0 + ai * 128 + m * 16;
                bf16_t* rowp = O + (size_t)row * ldc + col0;
#pragma unroll
                for (int bj = 0; bj < 2; ++bj) {
                    f32x4 v0 = acc[ai][bj][m][0], v1 = acc[ai][bj][m][1];
                    if (MODE == 1 && u.pn < 8) {
                        const int s = row & (SEQ - 1);
                        const int t0 = ((col0 + bj * 128) & 127) >> 1;
                        const f32x2* tp = rope + (t0 < 32 ? ((s >> 6) * 32 + t0) : ((256 + (s & 63)) * 32 + (t0 - 32)));
                        const f32x4 c01 = *(const f32x4*)tp, c23 = *(const f32x4*)(tp + 2);
                        const float sc = (u.pn < 6) ? QSCALE : 1.0f;
                        f32x4 r0, r1;
                        r0[0] = (v0[0] * c01[0] - v0[1] * c01[1]) * sc; r0[1] = (v0[1] * c01[0] + v0[0] * c01[1]) * sc;
                        r0[2] = (v0[2] * c01[2] - v0[3] * c01[3]) * sc; r0[3] = (v0[3] * c01[2] + v0[2] * c01[3]) * sc;
                        r1[0] = (v1[0] * c23[0] - v1[1] * c23[1]) * sc; r1[1] = (v1[1] * c23[0] + v1[0] * c23[1]) * sc;
                        r1[2] = (v1[2] * c23[2] - v1[3] * c23[3]) * sc; r1[3] = (v1[3] * c23[2] + v1[2] * c23[3]) * sc;
                        v0 = r0; v1 = r1;
                    }
                    u32x4 w; w.x = cvt_pk_bf16(v0[0], v0[1]); w.y = cvt_pk_bf16(v0[2], v0[3]); w.z = cvt_pk_bf16(v1[0], v1[1]); w.w = cvt_pk_bf16(v1[2], v1[3]);
                    *(u32x4*)(rowp + bj * 128) = w;
                }
            }
    }
};
struct EpiRes {
    static constexpr bool PERM = false, AFTER_DRAIN = false;
    const float* base; float* out; const float* gate;
    __device__ __forceinline__ void operator()(const f32x4 (&acc)[2][2][4][2], const pg8::Unit& u, int wr, int wc, int fr, int fq) const {
        const int row0 = u.pm * 256 + wr * 64 + fr, col0 = u.pn * 256 + wc * 32 + 4 * fq;
        const float* gp = gate + (size_t)(u.pm >> 6) * 6144 + col0;
        f32x4 gv[2][2];
#pragma unroll
        for (int bj = 0; bj < 2; ++bj)
#pragma unroll
            for (int n = 0; n < 2; ++n) gv[bj][n] = *(const f32x4*)(gp + bj * 128 + n * 16);
#pragma unroll
        for (int ai = 0; ai < 2; ++ai)
#pragma unroll
            for (int m = 0; m < 4; ++m) {
                const size_t off = (size_t)(row0 + ai * 128 + m * 16) * DM + col0;
#pragma unroll
                for (int bj = 0; bj < 2; ++bj)
#pragma unroll
                    for (int n = 0; n < 2; ++n) {
                        const f32x4 bs = *(const f32x4*)(base + off + bj * 128 + n * 16);
                        *(f32x4*)(out + off + bj * 128 + n * 16) = bs + gv[bj][n] * acc[ai][bj][m][n];
                    }
                asm volatile("" ::: "memory");
            }
    }
};
struct EpiResNext {
    static constexpr bool PERM = true, AFTER_DRAIN = false;
    const float* base; float* out; const float* gate; bf16_t* hu; const float* gnext; const float* scnext; float* rss;
    __device__ __forceinline__ void operator()(const f32x4 (&acc)[2][2][4][2], const pg8::Unit& u, int wr, int wc, int fr, int fq) const {
        const int row0 = u.pm * 256 + wr * 64 + fr, col0 = u.pn * 256 + wc * 32 + 8 * fq, b = u.pm >> 6;
        float ss[8];
#pragma unroll
        for (int i = 0; i < 8; ++i) ss[i] = 0.f;
#pragma unroll
        for (int bj = 0; bj < 2; ++bj) {
            const int col = col0 + bj * 128;
            const f32x4 gv0 = *(const f32x4*)(gate + (size_t)b * 6144 + col), gv1 = *(const f32x4*)(gate + (size_t)b * 6144 + col + 4);
#pragma unroll
            for (int ai = 0; ai < 2; ++ai)
#pragma unroll
                for (int m = 0; m < 4; ++m) {
                    const size_t off = (size_t)(row0 + ai * 128 + m * 16) * DM + col;
                    const f32x4 x0 = __builtin_nontemporal_load((const f32x4*)(base + off)) + gv0 * acc[ai][bj][m][0];
                    const f32x4 x1 = __builtin_nontemporal_load((const f32x4*)(base + off + 4)) + gv1 * acc[ai][bj][m][1];
                    __builtin_nontemporal_store(x0, (f32x4*)(out + off)); __builtin_nontemporal_store(x1, (f32x4*)(out + off + 4));
                    ss[ai * 4 + m] += ((x0[0] * x0[0] + x0[1] * x0[1]) + (x0[2] * x0[2] + x0[3] * x0[3])) + ((x1[0] * x1[0] + x1[1] * x1[1]) + (x1[2] * x1[2] + x1[3] * x1[3]));
                    const f32x4 cf0 = *(const f32x4*)(gnext + col) * (1.0f + *(const f32x4*)(scnext + (size_t)b * 6144 + col));
                    const f32x4 cf1 = *(const f32x4*)(gnext + col + 4) * (1.0f + *(const f32x4*)(scnext + (size_t)b * 6144 + col + 4));
                    *(bf16x8*)(hu + off) = pack8(x0 * cf0, x1 * cf1);
                    if (m & 1) asm volatile("" ::: "memory");
                }
        }
#pragma unroll
        for (int i = 0; i < 8; ++i) {
            float v = ss[i]; v += __shfl_xor(v, 16); v += __shfl_xor(v, 32);
            if (fq == 0) (void)__hip_atomic_fetch_add(rss + row0 + (i >> 2) * 128 + (i & 3) * 16, v, __ATOMIC_RELAXED, __HIP_MEMORY_SCOPE_AGENT);
        }
    }
};
struct EpiBNorm {
    static constexpr bool PERM = true, AFTER_DRAIN = false;
    bf16_t* O; int ldc; const float* rss; const float* bias;
    __device__ __forceinline__ void operator()(const f32x4 (&acc)[2][2][4][2], const pg8::Unit& u, int wr, int wc, int fr, int fq) const {
        const int row0 = u.pm * 256 + wr * 64 + fr, col0 = u.pn * 256 + wc * 32 + 8 * fq;
        const float* bp = bias + (size_t)(u.pm >> 6) * ldc + col0;
        f32x4 bv[2][2];
#pragma unroll
        for (int bj = 0; bj < 2; ++bj)
#pragma unroll
            for (int n = 0; n < 2; ++n) bv[bj][n] = *(const f32x4*)(bp + bj * 128 + 4 * n);
#pragma unroll
        for (int ai = 0; ai < 2; ++ai)
#pragma unroll
            for (int m = 0; m < 4; ++m) {
                const int row = row0 + ai * 128 + m * 16;
                const float rs = rsqrtf(rss[row] * (1.0f / 2048.0f) + 1e-6f);
                bf16_t* rowp = O + (size_t)row * ldc + col0;
#pragma unroll
                for (int bj = 0; bj < 2; ++bj) {
                    const f32x4 v0 = acc[ai][bj][m][0] * rs + bv[bj][0], v1 = acc[ai][bj][m][1] * rs + bv[bj][1];
                    u32x4 w; w.x = cvt_pk_bf16(v0[0], v0[1]); w.y = cvt_pk_bf16(v0[2], v0[3]); w.z = cvt_pk_bf16(v1[0], v1[1]); w.w = cvt_pk_bf16(v1[2], v1[3]);
                    *(u32x4*)(rowp + bj * 128) = w;
                }
            }
    }
};
struct EpiGateB {
    static constexpr bool PERM = true, AFTER_DRAIN = false;
    bf16_t* O; const float* gate;
    __device__ __forceinline__ void operator()(const f32x4 (&acc)[2][2][4][2], const pg8::Unit& u, int wr, int wc, int fr, int fq) const {
        const int row0 = u.pm * 256 + wr * 64 + fr, col0 = u.pn * 256 + wc * 32 + 8 * fq;
        const float* gp = gate + (size_t)(u.pm >> 6) * 6144 + col0;
        f32x4 gv[2][2];
#pragma unroll
        for (int bj = 0; bj < 2; ++bj)
#pragma unroll
            for (int n = 0; n < 2; ++n) gv[bj][n] = *(const f32x4*)(gp + bj * 128 + 4 * n);
#pragma unroll
        for (int ai = 0; ai < 2; ++ai)
#pragma unroll
            for (int m = 0; m < 4; ++m) {
                bf16_t* rowp = O + (size_t)(row0 + ai * 128 + m * 16) * DM + col0;
#pragma unroll
                for (int bj = 0; bj < 2; ++bj) *(bf16x8*)(rowp + bj * 128) = pack8(acc[ai][bj][m][0] * gv[bj][0], acc[ai][bj][m][1] * gv[bj][1]);
            }
    }
};
struct OneUnit {
    int has; pg8::Unit u;
    __device__ bool next(int i, pg8::Unit& o) const { if (i > 0 || !has) return false; o = u; return true; }
    __device__ __forceinline__ void a_ready(const pg8::Unit&) const {}
    __device__ __forceinline__ void done(const pg8::Unit&) const {}
};

__device__ __forceinline__ void transpose_tile(const float* W, int ldw, int k0, int n0, bf16_t* Wt, int ldt, int nd0, bool ropeperm, LAS bf16_t* tt) {
    const int tid = threadIdx.x;
#pragma unroll
    for (int it = 0; it < 8; ++it) {
        const int idx = it * 512 + tid, kk = idx >> 5, n4 = (idx & 31) * 4;
        const f32x4 v = *(const f32x4*)(W + (size_t)(k0 + kk) * ldw + n0 + n4);
#pragma unroll
        for (int e = 0; e < 4; ++e) {
            int nn = n4 + e;
            if (ropeperm) { const int hs = (nn >> 5) & 1, t = (nn & 31) + ((nn >> 6) << 5); nn = 2 * t + hs; }
            tt[nn * 132 + kk] = f2bf(v[e]);
        }
    }
    __syncthreads();
#pragma unroll
    for (int it = 0; it < 8; ++it) {
        const int idx = it * 512 + tid, nn = idx >> 5, ch = idx & 31;
        const u32x2 w = *(const LAS u32x2*)(tt + nn * 132 + ch * 4);
        *(u32x2*)(Wt + (size_t)(nd0 + nn) * ldt + k0 + ch * 4) = w;
    }
    __syncthreads();
}

__device__ void phase0(const Params& p, LAS unsigned char* lds) {
    const int tid = threadIdx.x;
    LAS float* sc = (LAS float*)lds;
    LAS float* red = (LAS float*)(lds + 24576);
    LAS float* trig = (LAS float*)(lds + 49152);
    LAS bf16_t* tt = (LAS bf16_t*)(lds + 53248);
    unsigned char* ws = p.ws;
    for (int i = tid; i < 3 * DM; i += 512) { const int r = i >> 11, k = i & 2047; const float v = r < 2 ? p.c[r * DM + k] : p.c_ctx[k]; sc[i] = silu(v); }
    if (tid < 128) { float s, c; sincospif((float)tid * (1.0f / 64.0f), &s, &c); trig[tid] = c; trig[128 + tid] = s; }
    __syncthreads();
    constexpr int J0 = 192, J1 = J0 + 640, J2 = J1 + 256, J3 = J2 + 256, J4 = J3 + 256, J5 = J4 + 64, J6 = J5 + 256, J7 = J6 + 20, J8 = J7 + 64, J9 = J8 + 128, J10 = J9 + 256, J11 = J10 + 64;
    for (int job = blockIdx.x; job < J11; job += gridDim.x) {
        if (job < J0) {
            const int L = job / 96, cc = job % 96;
            const float* wm = L ? p.l1_w_mod : p.l0_w_mod; const float* bm = L ? p.l1_b_mod : p.l0_b_mod;
            const int sub = tid & 15, rg = tid >> 4, col = cc * 64 + sub * 4;
            f32x4 a0 = {0.f, 0.f, 0.f, 0.f}, a1 = a0, a2 = a0;
            const float* wp = wm + (size_t)(rg * 64) * 6144 + col;
#pragma unroll 8
            for (int i = 0; i < 64; ++i) {
                const f32x4 w = *(const f32x4*)(wp + (size_t)i * 6144);
                const int k = rg * 64 + i;
                a0 += sc[k] * w; a1 += sc[2048 + k] * w; a2 += sc[4096 + k] * w;
            }
#pragma unroll
            for (int e = 0; e < 4; ++e) { red[(rg * 3 + 0) * 64 + sub * 4 + e] = a0[e]; red[(rg * 3 + 1) * 64 + sub * 4 + e] = a1[e]; red[(rg * 3 + 2) * 64 + sub * 4 + e] = a2[e]; }
            __syncthreads();
            if (tid < 192) {
                const int r = tid >> 6, cl = tid & 63; float s = bm[cc * 64 + cl];
                for (int g = 0; g < 32; ++g) s += red[(g * 3 + r) * 64 + cl];
                ((float*)(ws + WS_MOD))[(size_t)(L * 3 + r) * 6144 + cc * 64 + cl] = s;
            }
            __syncthreads();
        } else if (job < J1) {
            const int j = job - J0, nt = j % 40, kt = j / 40;
            transpose_tile(p.l0_w_in, 5120, kt * 128, nt * 128, (bf16_t*)(ws + WS_WTIN0), 2048, nt * 128, nt < 16, tt);
        } else if (job < J2) {
            const int j = job - J1, nt = j & 15, kt = j >> 4;
            transpose_tile(p.l0_w_out, 2048, kt * 128, nt * 128, (bf16_t*)(ws + WS_WTOUT0), 2048, nt * 128, false, tt);
        } else if (job < J3) {
            const int j = job - J2, nt = j & 15, kt = j >> 4;
            transpose_tile(p.l1_w_in, 4096, kt * 128, 2048 + nt * 128, (bf16_t*)(ws + WS_WTIN1), 2048, 2048 + nt * 128, false, tt);
        } else if (job < J4) {
            const int j = job - J3, nt = j & 15, kt = j >> 4;
            transpose_tile(p.l1_w_out, 2048, kt * 128, nt * 128, (bf16_t*)(ws + WS_WTOUT1), 2048, nt * 128, false, tt);
        } else if (job < J5) {
            const int j = job - J4, g = j >> 4, nt = j & 3, kt = (j >> 2) & 3;
            transpose_tile(p.l1_w_grp + (size_t)g * 262144, 512, kt * 128, nt * 128, (bf16_t*)(ws + WS_WGRPT) + (size_t)g * 262144, 512, nt * 128, false, tt);
        } else if (job < J6) {
            const int j = job - J5;
#pragma unroll
            for (int q = 0; q < 4; ++q) {
                const int e = (q * 512 + tid) * 8, row = j * 8 + (e >> 11), col = e & 2047;
                const float* sp = p.l1_w_in + (size_t)row * 4096 + col;
                const f32x4 v0 = *(const f32x4*)sp, v1 = *(const f32x4*)(sp + 4);
                *(bf16x8*)((bf16_t*)(ws + WS_WBF1) + (size_t)row * 2048 + col) = pack8(v0, v1);
            }
        } else if (job < J7) {
            const int e = (job - J6) * 512 + tid, pos = e >> 5, t = e & 31;
            const float pv = (float)(pos < 256 ? pos : pos - 256);
            const float inv = exp2f(-(float)t * (13.287712379549449f / 32.0f));
            float xr = pv * inv * 0.3183098861837907f;
            xr = xr - 2.0f * rintf(xr * 0.5f);
            float s, c; sincospif(xr, &s, &c);
            ((f32x2*)(ws + WS_ROPE))[e] = (f32x2){c, s};
        } else if (job < J8) {
            const int e = (job - J7) * 512 + tid, row = e >> 7, n1 = e & 127, kind = row >> 7, k1 = row & 127, ix = (k1 * n1) & 127;
            ((bf16_t*)(ws + WS_DC))[e] = f2bf(kind ? -trig[128 + ix] : trig[ix]);
        } else if (job < J9) {
            const int e = (job - J8) * 512 + tid, row = e >> 8, col = e & 255, kp = row >> 7, k2 = row & 127, kd = col >> 7, n2 = col & 127, ix = (k2 * n2) & 127;
            const float c = trig[ix], s = trig[128 + ix];
            ((bf16_t*)(ws + WS_EC))[e] = f2bf(kp == 0 ? (kd == 0 ? c : s) : (kd == 0 ? -s : c));
        } else if (job >= J10) {
            ((float*)(ws + WS_RSS))[(job - J10) * 512 + tid] = 0.f;
        } else {
            const int e = (job - J9) * 512 + tid, kc = e & 255, dp = (e >> 8) & 127, g = e >> 15, kind = kc >> 7;
            const int c = 32 * ((kc >> 5) & 3) + 16 * ((kc >> 2) & 1) + 4 * ((kc >> 3) & 3) + (kc & 3);
            const float* wf = p.l0_w_f + (size_t)g * 16384 + dp; float s = 0.f;
            for (int m = 0; m < 128; ++m) s += trig[kind * 128 + ((m * c) & 127)] * wf[m * 128];
            ((bf16_t*)(ws + WS_MGT))[(size_t)(g * 128 + dp) * 256 + kc] = f2bf(s * 6.905339660024878e-4f);
        }
    }
}

__device__ __forceinline__ void row_load8(const float* s, int lane, f32x4 (&v)[8]) {
#pragma unroll
    for (int j = 0; j < 8; ++j) v[j] = __builtin_nontemporal_load(((const f32x4*)s) + lane + 64 * j);
}
__device__ __forceinline__ float row_rstd(const f32x4 (&v)[8]) {
    float ss = 0.f;
#pragma unroll
    for (int j = 0; j < 8; ++j) ss += (v[j][0] * v[j][0] + v[j][1] * v[j][1]) + (v[j][2] * v[j][2] + v[j][3] * v[j][3]);
#pragma unroll
    for (int o = 32; o >= 1; o >>= 1) ss += __shfl_xor(ss, o);
    return rsqrtf(ss * (1.0f / 2048.0f) + 1e-6f);
}
struct NormArgs { const float* src; bf16_t* dst; const float* gamma; const float* modL; const float* ctx; bf16_t* hc; };
__device__ __forceinline__ const float* nm_src(const NormArgs& a, int r) { return r < MTOK ? a.src + (size_t)r * DM : a.ctx + (size_t)(r - MTOK) * DM; }
__device__ __forceinline__ void nm_finish(const NormArgs& a, int r, int lane, const f32x4 (&v)[8]) {
    bf16_t* d = r < MTOK ? a.dst + (size_t)r * DM : a.hc + (size_t)(r - MTOK) * DM;
    const float* mr = a.modL + (r < MTOK ? (r >> 14) : 2) * 6144;
    const float rs = row_rstd(v);
#pragma unroll
    for (int j = 0; j < 8; ++j) {
        const int c4 = lane + 64 * j;
        const f32x4 g = ((const f32x4*)a.gamma)[c4], sh = ((const f32x4*)mr)[c4], scl = ((const f32x4*)mr)[512 + c4];
        const f32x4 y = (v[j] * rs) * g * (1.0f + scl) + sh;
        *(u32x2*)(d + 4 * c4) = pack4(y);
    }
}
__device__ void norm_mod_phase(const float* src, bf16_t* dst, const float* gamma, const float* modL, const float* ctx, bf16_t* hc) {
    const int lane = threadIdx.x & 63, gw = blockIdx.x * 8 + (threadIdx.x >> 6), nw = gridDim.x * 8;
    const int total = ctx ? MTOK + 512 : MTOK;
    const NormArgs a{src, dst, gamma, modL, ctx, hc};
#ifdef REP_NORM
    for (int rep = 1; rep < REP_NORM; ++rep) { f32x4 vt[8]; for (int rr = gw; rr < total; rr += nw) { row_load8(nm_src(a, rr), lane, vt); nm_finish(a, rr, lane, vt); } }
#endif
    f32x4 va[8], vb[8];
    int r = gw;
    if (r < total) row_load8(nm_src(a, r), lane, va);
    while (r < total) {
        const int r2 = r + nw;
        if (r2 < total) row_load8(nm_src(a, r2), lane, vb);
        nm_finish(a, r, lane, va);
        if (r2 >= total) break;
        const int r3 = r2 + nw;
        if (r3 < total) row_load8(nm_src(a, r3), lane, va);
        nm_finish(a, r2, lane, vb);
        r = r3;
    }
}
__device__ __forceinline__ void fn_finish(float* io, const bf16_t* delta, const float* gamma, int r, int lane, f32x4 (&v)[8], const u32x2 (&dv)[8]) {
    f32x4* s = (f32x4*)(io + (size_t)r * DM);
#pragma unroll
    for (int j = 0; j < 8; ++j) v[j] += unpack4(dv[j]);
    const float rs = row_rstd(v);
#pragma unroll
    for (int j = 0; j < 8; ++j) __builtin_nontemporal_store((v[j] * rs) * ((const f32x4*)gamma)[lane + 64 * j], s + lane + 64 * j);
}
__device__ __forceinline__ void drow_load8(const bf16_t* s, int lane, u32x2 (&v)[8]) {
#pragma unroll
    for (int j = 0; j < 8; ++j) v[j] = __builtin_nontemporal_load(((const u32x2*)s) + lane + 64 * j);
}
__device__ void final_norm_phase(float* io, const bf16_t* delta, const float* gamma) {
    const int lane = threadIdx.x & 63, gw = blockIdx.x * 8 + (threadIdx.x >> 6), nw = gridDim.x * 8;
    f32x4 va[8], vb[8]; u32x2 da[8], db[8];
    int r = gw;
    if (r < MTOK) { row_load8(io + (size_t)r * DM, lane, va); drow_load8(delta + (size_t)r * DM, lane, da); }
    while (r < MTOK) {
        const int r2 = r + nw;
        if (r2 < MTOK) { row_load8(io + (size_t)r2 * DM, lane, vb); drow_load8(delta + (size_t)r2 * DM, lane, db); }
        fn_finish(io, delta, gamma, r, lane, va, da);
        if (r2 >= MTOK) break;
        const int r3 = r2 + nw;
        if (r3 < MTOK) { row_load8(io + (size_t)r3 * DM, lane, va); drow_load8(delta + (size_t)r3 * DM, lane, da); }
        fn_finish(io, delta, gamma, r2, lane, vb, db);
        r = r3;
    }
}

__device__ void bias1_phase(const bf16_t* Wt, const float* mod1, float* bias) {
    const int lane = threadIdx.x & 63, gw = blockIdx.x * 8 + (threadIdx.x >> 6), nw = gridDim.x * 8;
    for (int col = gw; col < 4096; col += nw) {
        float s0 = 0.f, s1 = 0.f;
#pragma unroll
        for (int j = 0; j < 4; ++j) {
            const int k = (j * 64 + lane) * 8;
            const u32x4 wv = *(const u32x4*)(Wt + (size_t)col * 2048 + k);
            const float w8[8] = {bflo(wv.x), bfhi(wv.x), bflo(wv.y), bfhi(wv.y), bflo(wv.z), bfhi(wv.z), bflo(wv.w), bfhi(wv.w)};
            const f32x4 a0 = *(const f32x4*)(mod1 + k), a1 = *(const f32x4*)(mod1 + k + 4), b0 = *(const f32x4*)(mod1 + 6144 + k), b1 = *(const f32x4*)(mod1 + 6144 + k + 4);
            s0 += w8[0] * a0[0] + w8[1] * a0[1] + w8[2] * a0[2] + w8[3] * a0[3] + w8[4] * a1[0] + w8[5] * a1[1] + w8[6] * a1[2] + w8[7] * a1[3];
            s1 += w8[0] * b0[0] + w8[1] * b0[1] + w8[2] * b0[2] + w8[3] * b0[3] + w8[4] * b1[0] + w8[5] * b1[1] + w8[6] * b1[2] + w8[7] * b1[3];
        }
#pragma unroll
        for (int o = 32; o >= 1; o >>= 1) { s0 += __shfl_xor(s0, o); s1 += __shfl_xor(s1, o); }
        if (lane == 0) { bias[col] = s0; bias[4096 + col] = s1; }
    }
}

__device__ void fourier_a_phase(const bf16_t* qkv, const bf16_t* Dc, bf16_t* Y, LAS unsigned char* lds) {
    const int tid = threadIdx.x, lane = tid & 63, w = __builtin_amdgcn_readfirstlane(tid >> 6), g = lane >> 4, li = lane & 15, qq = li >> 2, pp = li & 3;
    const int k1 = 16 * w + li;
    bf16x8 db[2][4];
#pragma unroll
    for (int kd = 0; kd < 2; ++kd)
#pragma unroll
        for (int ks = 0; ks < 4; ++ks) db[kd][ks] = *(const bf16x8*)(Dc + (size_t)(kd * 128 + k1) * 128 + 32 * ks + 8 * g);
    const int fa_first = (gridDim.x > 64) ? (int)blockIdx.x - 8 : (int)blockIdx.x, fa_step = (gridDim.x > 64) ? (int)gridDim.x - 8 : (int)gridDim.x;
    for (int job0 = (fa_first < 0) ? 512 * REP_FA : fa_first; job0 < 512 * REP_FA; job0 += fa_step) {
        const int job = job0 & 511;
        const int chalf = job & 1, n2 = (job >> 1) & 127, b = job >> 8;
#pragma unroll
        for (int it = 0; it < 8; ++it) {
            const int idx = it * 512 + tid, r = idx >> 5, ch = idx & 31;
            const u32x4 v = *(const u32x4*)(qkv + ((size_t)b * SEQ + 128 * r + n2) * LDQ + OFF_F + 256 * chalf + ch * 8);
            *(LAS u32x4*)(lds + r * 528 + ch * 16) = v;
        }
        __syncthreads();
        float sn, cs; sincospif((float)((n2 * k1) & 16383) * (1.0f / 8192.0f), &sn, &cs);
        LAS unsigned char* fb = lds + (8 * g + qq) * 528 + 16 * pp;
        for (int c2 = 0; c2 < 2; ++c2) {
            f32x4 acc[8][2];
#pragma unroll
            for (int ct = 0; ct < 8; ++ct) { acc[ct][0] = (f32x4){0.f, 0.f, 0.f, 0.f}; acc[ct][1] = acc[ct][0]; }
#pragma unroll
            for (int ks = 0; ks < 4; ++ks)
#pragma unroll
                for (int ct = 0; ct < 8; ++ct) {
                    LAS unsigned char* a = fb + ks * 32 * 528 + (128 * c2 + 32 * (ct >> 1) + 4 * (ct & 1)) * 2;
                    const bf16x8 af = tr2(a, a + 4 * 528);
                    acc[ct][0] = mfma16(af, db[0][ks], acc[ct][0]);
                    acc[ct][1] = mfma16(af, db[1][ks], acc[ct][1]);
                }
            bf16_t* yr = Y + ((((size_t)b * 128 + k1) * 2 + 0) * 128 + n2) * 512 + 256 * chalf + 128 * c2 + 8 * g;
            bf16_t* yi = yr + (size_t)128 * 512;
#pragma unroll
            for (int k = 0; k < 4; ++k) {
                const f32x4 a0 = acc[2 * k][0], b0 = acc[2 * k][1], a1 = acc[2 * k + 1][0], b1 = acc[2 * k + 1][1];
                *(bf16x8*)(yr + 32 * k) = pack8(a0 * cs + b0 * sn, a1 * cs + b1 * sn);
                *(bf16x8*)(yi + 32 * k) = pack8(b0 * cs - a0 * sn, b1 * cs - a1 * sn);
            }
        }
        __syncthreads();
    }
}
__device__ void fourier_b_phase(const bf16_t* Y, const bf16_t* Ec, const bf16_t* MgT, const bf16_t* qkv, bf16_t* A0, LAS unsigned char* lds) {
    const int tid = threadIdx.x, lane = tid & 63, w = __builtin_amdgcn_readfirstlane(tid >> 6), g = lane >> 4, li = lane & 15, qq = li >> 2, pp = li & 3;
    const bool mlds = (gridDim.x & 3) == 0;
    LAS unsigned char* ms = lds + 69632;
    if (mlds) {
#pragma unroll
        for (int it = 0; it < 8; ++it) {
            const int idx = it * 512 + tid, r = idx >> 5, ch = idx & 31;
            *(LAS u32x4*)(ms + r * 528 + ch * 16) = *(const u32x4*)(MgT + (size_t)((blockIdx.x & 3) * 128 + r) * 256 + ch * 8);
        }
    }
    for (int job0 = blockIdx.x; job0 < 1024 * REP_FB; job0 += gridDim.x) {
        const int job = job0 & 1023;
        const int grp = job & 3, k1 = (job >> 2) & 127, b = job >> 9;
#pragma unroll
        for (int it = 0; it < 8; ++it) {
            const int idx = it * 512 + tid, r = idx >> 4, ch = idx & 15;
            const u32x4 v = *(const u32x4*)(Y + (((size_t)b * 128 + k1) * 256 + r) * 512 + 128 * grp + ch * 8);
            *(LAS u32x4*)(lds + r * 272 + ch * 16) = v;
        }
        __syncthreads();
        const int k2 = 16 * w + li;
        f32x4 acc[8][2];
#pragma unroll
        for (int ct = 0; ct < 8; ++ct) { acc[ct][0] = (f32x4){0.f, 0.f, 0.f, 0.f}; acc[ct][1] = acc[ct][0]; }
        LAS unsigned char* yb = lds + (8 * g + qq) * 272 + 8 * pp;
        const bf16_t* e0 = Ec + (size_t)k2 * 256 + 8 * g;
#pragma unroll 2
        for (int ks = 0; ks < 8; ++ks) {
            const bf16x8 eb0 = *(const bf16x8*)(e0 + 32 * ks), eb1 = *(const bf16x8*)(e0 + 128 * 256 + 32 * ks);
#pragma unroll
            for (int ct = 0; ct < 8; ++ct) {
                LAS unsigned char* a = yb + ks * 32 * 272 + 32 * ct;
                const bf16x8 af = tr2(a, a + 4 * 272);
                acc[ct][0] = mfma16(af, eb0, acc[ct][0]);
                acc[ct][1] = mfma16(af, eb1, acc[ct][1]);
            }
        }
        f32x4 o2[8];
#pragma unroll
        for (int dt = 0; dt < 8; ++dt) o2[dt] = (f32x4){0.f, 0.f, 0.f, 0.f};
        const bf16_t* mg = MgT + (size_t)(grp * 128 + 8 * (li >> 2) + (li & 3)) * 256 + 8 * g;
#pragma unroll
        for (int kp = 0; kp < 2; ++kp)
#pragma unroll
            for (int ks = 0; ks < 4; ++ks) {
                const bf16x8 bfr = pack8(acc[2 * ks][kp], acc[2 * ks + 1][kp]);
#pragma unroll
                for (int dt = 0; dt < 8; ++dt) {
                    const bf16x8 af = mlds ? *(const LAS bf16x8*)(ms + (8 * (li >> 2) + (li & 3) + 32 * (dt >> 1) + 4 * (dt & 1)) * 528 + (kp * 4 + ks) * 64 + 16 * g)
                                           : *(const bf16x8*)(mg + (size_t)(32 * (dt >> 1) + 4 * (dt & 1)) * 256 + (kp * 4 + ks) * 32);
                    o2[dt] = mfma16(af, bfr, o2[dt]);
                }
            }
        const size_t row = (size_t)b * SEQ + k1 + 128 * k2;
        const bf16_t* zp = qkv + row * LDQ + OFF_Z + 1536 + grp * 128 + 8 * g;
        bf16_t* op = A0 + row * DM + 1536 + grp * 128 + 8 * g;
#pragma unroll
        for (int k = 0; k < 4; ++k) {
            const u32x4 zv = *(const u32x4*)(zp + 32 * k);
            const f32x4 z0 = unpack4((u32x2){zv.x, zv.y}), z1 = unpack4((u32x2){zv.z, zv.w});
            *(bf16x8*)(op + 32 * k) = pack8(o2[2 * k] * silu4(z0), o2[2 * k + 1] * silu4(z1));
        }
        __syncthreads();
    }
}

__device__ void attn_phase(const bf16_t* qkv, const bf16_t* kcvc, const float* sink, bf16_t* A0, LAS unsigned char* lds) {
    const int tid = threadIdx.x, lane = tid & 63, w = __builtin_amdgcn_readfirstlane(tid >> 6), g = lane >> 4, li = lane & 15, qq = li >> 2, pp = li & 3;
    const int sr = tid >> 2, sc4 = tid & 3;
    const int vcu = (gridDim.x & 7) == 0 ? (int)(blockIdx.x & 7) * (int)(gridDim.x >> 3) + (int)(blockIdx.x >> 3) : (int)blockIdx.x;
    const int per = (1536 * REP_ATT + (int)gridDim.x - 1) / (int)gridDim.x;
    const int it_end = min((vcu + 1) * per, 1536 * REP_ATT);
    for (int it0 = vcu * per; it0 < it_end; ++it0) {
        const int it = it0 % 1536;
        const int h = it % 12, np = (it / 12) & 63, b = it / 768, kvh = h / 3;
        const size_t rowbase = (size_t)b * SEQ + np * 256 + 32 * w;
        bf16x8 qf[2][4]; float mrun[2], lrun[2]; f32x4 o[2][8];
        const float sk = sink[h] * LOG2E;
#pragma unroll
        for (int qt = 0; qt < 2; ++qt) {
            const bf16_t* qp = qkv + (rowbase + 16 * qt + li) * LDQ + h * 128 + 8 * g;
#pragma unroll
            for (int ks = 0; ks < 4; ++ks) qf[qt][ks] = *(const bf16x8*)(qp + 32 * ks);
            mrun[qt] = sk; lrun[qt] = (g == 0) ? 1.0f : 0.0f;
#pragma unroll
            for (int dt = 0; dt < 8; ++dt) o[qt][dt] = (f32x4){0.f, 0.f, 0.f, 0.f};
        }
        const int wstart = (np == 0) ? 1 : 0, wend = (np == 63) ? 3 : 4, cnt = 2 + (wend - wstart);
        u32x4 kr[4], vr[4];
#define ATT_LOAD(j) do { const bf16_t* kp_; \
            if ((j) < 2) kp_ = kcvc + ((size_t)b * 256 + 128 * (j) + sr) * 1024 + kvh * 128; \
            else kp_ = qkv + ((size_t)b * SEQ + np * 256 - 128 + ((j) - 2 + wstart) * 128 + sr) * LDQ + OFF_K + kvh * 128; \
            _Pragma("unroll") for (int i_ = 0; i_ < 4; ++i_) { kr[i_] = *(const u32x4*)(kp_ + (sc4 + 4 * i_) * 8); vr[i_] = *(const u32x4*)(kp_ + 512 + (sc4 + 4 * i_) * 8); } } while (0)
#define ATT_STORE(buf) do { LAS unsigned char* kd_ = lds + (buf) * 34816 + sr * 272 + sc4 * 16; LAS unsigned char* vd_ = lds + 69632 + (buf) * 36864 + sr * 288 + sc4 * 16; \
            _Pragma("unroll") for (int i_ = 0; i_ < 4; ++i_) { *(LAS u32x4*)(kd_ + 64 * i_) = kr[i_]; *(LAS u32x4*)(vd_ + 64 * i_) = vr[i_]; } } while (0)
        ATT_LOAD(0); ATT_STORE(0);
        __syncthreads();
        for (int j2 = 0; j2 < cnt; ++j2) {
            if (j2 + 1 < cnt) ATT_LOAD(j2 + 1);
#pragma unroll 1
          for (int hf = 0; hf < 2; ++hf) {
            const int tw = 2 * (j2 - 2 + wstart) + hf;
            const int kpos0 = np * 256 - 128 + tw * 64;
            const int q0 = np * 256 + 32 * w;
            const bool active = (j2 < 2) || (kpos0 + 63 >= q0 - 128 && kpos0 <= q0 + 31 + 128);
            if (active) {
                const bool needmask = (j2 >= 2) && !(kpos0 >= q0 + 31 - 128 && kpos0 + 63 <= q0 + 128);
                LAS unsigned char* kb = lds + (j2 & 1) * 34816 + hf * (64 * 272);
                LAS unsigned char* vb = lds + 69632 + (j2 & 1) * 36864 + hf * (64 * 288);
                f32x4 s[2][4];
#pragma unroll
                for (int qt = 0; qt < 2; ++qt)
#pragma unroll
                    for (int kt = 0; kt < 4; ++kt) s[qt][kt] = (f32x4){0.f, 0.f, 0.f, 0.f};
#pragma unroll
                for (int ks = 0; ks < 4; ++ks)
#pragma unroll
                    for (int kt = 0; kt < 4; ++kt) {
                        const bf16x8 kf = *(const LAS bf16x8*)(kb + (16 * kt + li) * 272 + (32 * ks + 8 * g) * 2);
#pragma unroll
                        for (int qt = 0; qt < 2; ++qt) s[qt][kt] = mfma16(kf, qf[qt][ks], s[qt][kt]);
                    }
                bf16x8 pf[2][2];
#pragma unroll
                for (int qt = 0; qt < 2; ++qt) {
                    if (needmask) {
                        const int qpos = np * 256 + 32 * w + 16 * qt + li;
#pragma unroll
                        for (int kt = 0; kt < 4; ++kt)
#pragma unroll
                            for (int r = 0; r < 4; ++r) { const int d = kpos0 + 16 * kt + 4 * g + r - qpos; if (d > 128 || d < -128) s[qt][kt][r] = -INFINITY; }
                    }
                    float mx = s[qt][0][0];
#pragma unroll
                    for (int kt = 0; kt < 4; ++kt)
#pragma unroll
                        for (int r = 0; r < 4; ++r) mx = fmaxf(mx, s[qt][kt][r]);
                    if (__builtin_amdgcn_ballot_w64(mx > mrun[qt] + 8.0f) != 0ull) {
                        mx = fmaxf(mx, __shfl_xor(mx, 16)); mx = fmaxf(mx, __shfl_xor(mx, 32));
                        const bool grow = mx > mrun[qt] + 8.0f;
                        const float mnew = grow ? mx : mrun[qt], alpha = __builtin_amdgcn_exp2f(mrun[qt] - mnew);
                        mrun[qt] = mnew; lrun[qt] *= alpha;
#pragma unroll
                        for (int dt = 0; dt < 8; ++dt) o[qt][dt] *= alpha;
                    }
                    const float mcur = mrun[qt];
                    float ls = 0.f;
#pragma unroll
                    for (int kt = 0; kt < 4; ++kt)
#pragma unroll
                        for (int r = 0; r < 4; ++r) { const float pe = __builtin_amdgcn_exp2f(s[qt][kt][r] - mcur); s[qt][kt][r] = pe; ls += pe; }
                    lrun[qt] += ls;
                    pf[qt][0] = pack8(s[qt][0], s[qt][1]); pf[qt][1] = pack8(s[qt][2], s[qt][3]);
                }
#pragma unroll
                for (int ks2 = 0; ks2 < 2; ++ks2)
#pragma unroll
                    for (int dt = 0; dt < 8; ++dt) {
                        LAS unsigned char* a = vb + (32 * ks2 + 4 * g + qq) * 288 + (32 * (dt >> 1) + 8 * pp + 4 * (dt & 1)) * 2;
                        const bf16x8 vf = tr2(a, a + 16 * 288);
#pragma unroll
                        for (int qt = 0; qt < 2; ++qt) o[qt][dt] = mfma16(vf, pf[qt][ks2], o[qt][dt]);
                    }
            }
          }
            if (j2 + 1 < cnt) ATT_STORE((j2 + 1) & 1);
            __syncthreads();
        }
#undef ATT_LOAD
#undef ATT_STORE
#pragma unroll
        for (int qt = 0; qt < 2; ++qt) {
            float lt = lrun[qt]; lt += __shfl_xor(lt, 16); lt += __shfl_xor(lt, 32);
            const float inv = 1.0f / lt;
            const bf16_t* zp = qkv + (rowbase + 16 * qt + li) * LDQ + OFF_Z + h * 128 + 8 * g;
            bf16_t* op = A0 + (rowbase + 16 * qt + li) * DM + h * 128 + 8 * g;
#pragma unroll
            for (int k = 0; k < 4; ++k) {
                const u32x4 zv = *(const u32x4*)(zp + 32 * k);
                const f32x4 z0 = unpack4((u32x2){zv.x, zv.y}), z1 = unpack4((u32x2){zv.z, zv.w});
                *(bf16x8*)(op + 32 * k) = pack8(o[qt][2 * k] * inv * silu4(z0), o[qt][2 * k + 1] * inv * silu4(z1));
            }
        }
    }
}

__device__ void pool_phase(const bf16_t* uz, const float* lscale, bf16_t* A1) {
    const int tid = threadIdx.x, sub = tid >> 8, colo = (tid & 255) * 8, grp = colo >> 9, half = 1 << grp;
    float ls[8];
#pragma unroll
    for (int e = 0; e < 8; ++e) ls[e] = lscale[colo + e];
    for (int job0 = blockIdx.x; job0 < 512 * REP_POOL; job0 += gridDim.x) {
        const int job = job0 & 511;
        const int b = job >> 8, t0 = (job & 255) * 64 + sub * 32;
        const bf16_t* ub = uz + (size_t)b * SEQ * 4096 + colo;
        float S[8];
#pragma unroll
        for (int e = 0; e < 8; ++e) S[e] = 0.f;
        const int lo0 = max(t0 - half, 0), hi0 = min(t0 + half, SEQ);
        for (int j = lo0; j < hi0; ++j) {
            const u32x4 v = *(const u32x4*)(ub + (size_t)j * 4096);
            S[0] += bflo(v.x); S[1] += bfhi(v.x); S[2] += bflo(v.y); S[3] += bfhi(v.y); S[4] += bflo(v.z); S[5] += bfhi(v.z); S[6] += bflo(v.w); S[7] += bfhi(v.w);
        }
        for (int tc = t0; tc < t0 + 32; tc += 4) {
            u32x4 uv[4], zv[4], ua[4], us[4];
#pragma unroll
            for (int i = 0; i < 4; ++i) {
                const int t = tc + i;
                uv[i] = *(const u32x4*)(ub + (size_t)t * 4096); zv[i] = __builtin_nontemporal_load((const u32x4*)(ub + (size_t)t * 4096 + 2048));
                ua[i] = (t + half < SEQ) ? *(const u32x4*)(ub + (size_t)(t + half) * 4096) : (u32x4){0u, 0u, 0u, 0u};
                us[i] = (t - half >= 0) ? *(const u32x4*)(ub + (size_t)(t - half) * 4096) : (u32x4){0u, 0u, 0u, 0u};
            }
#pragma unroll
            for (int i = 0; i < 4; ++i) {
                const int t = tc + i;
                const int lo = max(t - half, 0), hi = min(t + half, SEQ);
                const float rc = 1.0f / (float)(hi - lo);
                const float u8[8] = {bflo(uv[i].x), bfhi(uv[i].x), bflo(uv[i].y), bfhi(uv[i].y), bflo(uv[i].z), bfhi(uv[i].z), bflo(uv[i].w), bfhi(uv[i].w)};
                const float z8[8] = {bflo(zv[i].x), bfhi(zv[i].x), bflo(zv[i].y), bfhi(zv[i].y), bflo(zv[i].z), bfhi(zv[i].z), bflo(zv[i].w), bfhi(zv[i].w)};
                float r8[8];
#pragma unroll
                for (int e = 0; e < 8; ++e) r8[e] = (S[e] * rc - u8[e]) * ls[e] * silu(z8[e]);
                u32x4 wv; wv.x = cvt_pk_bf16(r8[0], r8[1]); wv.y = cvt_pk_bf16(r8[2], r8[3]); wv.z = cvt_pk_bf16(r8[4], r8[5]); wv.w = cvt_pk_bf16(r8[6], r8[7]);
                *(u32x4*)(A1 + ((size_t)b * SEQ + t) * DM + colo) = wv;
                S[0] += bflo(ua[i].x) - bflo(us[i].x); S[1] += bfhi(ua[i].x) - bfhi(us[i].x); S[2] += bflo(ua[i].y) - bflo(us[i].y); S[3] += bfhi(ua[i].y) - bfhi(us[i].y);
                S[4] += bflo(ua[i].z) - bflo(us[i].z); S[5] += bfhi(ua[i].z) - bfhi(us[i].z); S[6] += bflo(ua[i].w) - bflo(us[i].w); S[7] += bfhi(ua[i].w) - bfhi(us[i].w);
            }
        }
    }
}

__device__ __forceinline__ void grid_bar(unsigned* cnt, unsigned target) {
    asm volatile("s_waitcnt vmcnt(0)" ::: "memory");
    __syncthreads();
    if (threadIdx.x == 0) {
        __builtin_amdgcn_fence(__ATOMIC_RELEASE, "agent");
        asm volatile("s_waitcnt vmcnt(0)" ::: "memory");
        (void)__hip_atomic_fetch_add(cnt, 1u, __ATOMIC_RELAXED, __HIP_MEMORY_SCOPE_AGENT);
        unsigned sp = 0;
        while (__hip_atomic_load(cnt, __ATOMIC_RELAXED, __HIP_MEMORY_SCOPE_AGENT) < target) { __builtin_amdgcn_s_sleep(1); if (++sp > (1u << 24)) break; }
        __builtin_amdgcn_fence(__ATOMIC_ACQUIRE, "agent");
        asm volatile("s_waitcnt vmcnt(0)" ::: "memory");
    }
    __syncthreads();
}

#define XB_TMO      128
#define XB_XCNT(j)  (256  + 64 * (j))
#define XB_XSUB(j)  (1280 + 64 * (j))
#define XB_XGEN(j)  (2304 + 64 * (j))
#define XB_TOP      3328
#define XB_TOPGEN   3392
#define XB_SPIN_CAP (1u << 22)
__device__ __forceinline__ unsigned xb_ld(unsigned* p)              { return __hip_atomic_load(p, __ATOMIC_RELAXED, __HIP_MEMORY_SCOPE_AGENT); }
__device__ __forceinline__ unsigned xb_add(unsigned* p, unsigned v) { return __hip_atomic_fetch_add(p, v, __ATOMIC_RELAXED, __HIP_MEMORY_SCOPE_AGENT); }
__device__ __forceinline__ unsigned xb_xcc_id() { return (unsigned)__builtin_amdgcn_s_getreg((3 << 11) | 20) & 0xFu; }
#define XB_SPIN(cond, bar) do { unsigned _sp = 0; while (cond) { __builtin_amdgcn_s_sleep(1); \
    if ((++_sp & 255u) == 0u) { if (xb_ld(&(bar)[XB_TMO])) break; if (_sp > XB_SPIN_CAP) { atomicAdd(&(bar)[XB_TMO], 1u); break; } } } } while (0)
struct XcdBar { unsigned* bar; unsigned x, nloc, nx; };
__device__ __forceinline__ void xcd_bar(XcdBar& b) {
    asm volatile("s_waitcnt vmcnt(0)" ::: "memory");
    __syncthreads();
    if (threadIdx.x == 0) {
        unsigned* bar = b.bar;
        __builtin_amdgcn_s_waitcnt(0);
        if (b.nloc == 0u) {
            const unsigned G = gridDim.x; unsigned sum, cnt, mine, sp = 0u;
            for (;;) {
                sum = 0u; cnt = 0u; mine = 0u;
#pragma unroll
                for (unsigned j = 0; j < 16; ++j) { const unsigned c = xb_ld(&bar[XB_XCNT(j)]); sum += c; cnt += (c > 0u) ? 1u : 0u; mine = (j == b.x) ? c : mine; }
                if (sum == G) break;
                __builtin_amdgcn_s_sleep(1);
                if ((++sp & 255u) == 0u) { if (xb_ld(&bar[XB_TMO])) break; if (sp > XB_SPIN_CAP) { atomicAdd(&bar[XB_TMO], 1u); break; } }
            }
            b.nloc = mine > 0u ? mine : 1u; b.nx = cnt > 0u ? cnt : 1u;
        }
        const unsigned nloc = b.nloc, nx = b.nx;
        const unsigned old = xb_add(&bar[XB_XSUB(b.x)], 1u);
        const unsigned gen = old / nloc;
        if (old + 1u == (gen + 1u) * nloc) {
            __builtin_amdgcn_fence(__ATOMIC_RELEASE, "agent");
            asm volatile("s_waitcnt vmcnt(0)" ::: "memory");
            const unsigned og = xb_add(&bar[XB_TOP], 1u);
            const unsigned tg = og / nx;
            if (og + 1u == (tg + 1u) * nx) xb_add(&bar[XB_TOPGEN], 1u);
            else XB_SPIN(xb_ld(&bar[XB_TOPGEN]) == tg, bar);
            __builtin_amdgcn_fence(__ATOMIC_ACQUIRE, "agent");
            xb_add(&bar[XB_XGEN(b.x)], 1u);
            asm volatile("s_waitcnt vmcnt(0)" ::: "memory");
        } else {
            XB_SPIN(xb_ld(&bar[XB_XGEN(b.x)]) == gen, bar);
            __builtin_amdgcn_fence(__ATOMIC_ACQUIRE, "agent");
            asm volatile("s_waitcnt vmcnt(0)" ::: "memory");
        }
    }
    __syncthreads();
}

__global__ void __launch_bounds__(512, 2) fwd_mega(Params p) {
    extern __shared__ __attribute__((aligned(16))) unsigned char lds_raw[];
    LAS unsigned char* lds = (LAS unsigned char*)lds_raw;
    cg::grid_group grid = cg::this_grid();
    unsigned char* ws = p.ws;
    const float* mod = (const float*)(ws + WS_MOD);
    const f32x2* rope = (const f32x2*)(ws + WS_ROPE);
    bf16_t* Dc = (bf16_t*)(ws + WS_DC); bf16_t* Ec = (bf16_t*)(ws + WS_EC); bf16_t* MgT = (bf16_t*)(ws + WS_MGT);
    bf16_t* WtIn0 = (bf16_t*)(ws + WS_WTIN0); bf16_t* WtOut0 = (bf16_t*)(ws + WS_WTOUT0); bf16_t* WtIn1 = (bf16_t*)(ws + WS_WTIN1); bf16_t* WtOut1 = (bf16_t*)(ws + WS_WTOUT1);
    bf16_t* Wbf1 = (bf16_t*)(ws + WS_WBF1); bf16_t* WgrpT = (bf16_t*)(ws + WS_WGRPT);
    bf16_t* H = (bf16_t*)(ws + WS_H); bf16_t* HC = (bf16_t*)(ws + WS_HC); bf16_t* QKV = (bf16_t*)(ws + WS_QKV); bf16_t* KCVC = (bf16_t*)(ws + WS_KCVC);
    bf16_t* Y = (bf16_t*)(ws + WS_Y); bf16_t* AB = (bf16_t*)(ws + WS_A);
    float* RSS = (float*)(ws + WS_RSS); float* BIAS1 = (float*)(ws + WS_BIAS1);
    const int G = gridDim.x, bid = blockIdx.x;

    unsigned* barcnt = (unsigned*)(ws + WS_BAR); unsigned nbar = 0;
    XcdBar xbar; xbar.bar = (unsigned*)(ws + WS_XBAR); xbar.x = xb_xcc_id(); xbar.nloc = 0u; xbar.nx = 0u;
    if (threadIdx.x == 0) (void)xb_add(&xbar.bar[XB_XCNT(xbar.x)], 1u);
#ifdef USE_CG_SYNC
#define GRID_BAR() grid.sync()
#else
#ifdef USE_FLAT_BAR
#define GRID_BAR() do { ++nbar; grid_bar(barcnt, nbar * (unsigned)G); } while (0)
#else
#define GRID_BAR() xcd_bar(xbar)
#endif
#endif
    phase0(p, lds);
#if REP_P0 > 1
    __syncthreads(); phase0(p, lds); __syncthreads(); phase0(p, lds);
#endif
#ifdef USE_CG_SYNC
    grid.sync();
#else
    if (p.ws == nullptr) grid.sync();
    GRID_BAR();
#endif

    norm_mod_phase(p.x, H, p.l0_norm, mod, p.ctx, HC);
    GRID_BAR();

    {
        pg8::Gemm g{H, WtIn0, MTOK, 5120, 2048, 2048, 2048}; pg8::StaticOrder S; S.init(MTOK, 5120, G, bid);
        EpiB<1> E{QKV, LDQ, rope};
        pg8::gemm_phase<EpiB<1>, pg8::StaticOrder, false>(lds, g, S, E, nullptr);
#if REP_G0 > 1
        pg8::gemm_phase<EpiB<1>, pg8::StaticOrder, false>(lds, g, S, E, nullptr);
#endif
    }
    GRID_BAR();

    {
        pg8::Gemm g{HC, WtIn0 + (size_t)OFF_K * 2048, 512, 1024, 2048, 2048, 2048}; pg8::StaticOrder S; S.init(512, 1024, G, bid);
        EpiB<0> E{KCVC, 1024, nullptr};
        pg8::gemm_phase<EpiB<0>, pg8::StaticOrder, false>(lds, g, S, E, nullptr);
    }
    {
        const int fbk = (bid - 8) & 63, grp = fbk >> 4, wi = fbk & 15;
        pg8::Gemm g{WgrpT + (size_t)grp * 262144, Wbf1 + grp * 512, 512, 2048, 512, 512, 2048};
        OneUnit S{(G >= 72 ? (bid >= 8 && bid < 72) : (bid < 64)) ? 1 : 0, {wi >> 3, wi & 7}};
        EpiB<0> E{WtIn1 + (size_t)grp * 512 * 2048, 2048, nullptr};
        pg8::gemm_phase<EpiB<0>, OneUnit, false>(lds, g, S, E, nullptr);
    }
    fourier_a_phase(QKV, Dc, Y, lds);
    GRID_BAR();

    bias1_phase(WtIn1, mod + 3 * 6144, BIAS1);
    attn_phase(QKV, KCVC, p.l0_sink, AB, lds);
#if REP_P4 == 2
    attn_phase(QKV, KCVC, p.l0_sink, AB, lds);
#endif
    fourier_b_phase(Y, Ec, MgT, QKV, AB, lds);
#if REP_P4 == 3
    fourier_b_phase(Y, Ec, MgT, QKV, AB, lds);
#endif
#if REP_P4 == 4
    GRID_BAR();
    attn_phase(QKV, KCVC, p.l0_sink, AB, lds);
#endif
    GRID_BAR();

    {
        pg8::Gemm g{AB, WtOut0, MTOK, 2048, 2048, 2048, 2048}; pg8::StaticOrder S; S.init(MTOK, 2048, G, bid);
        EpiResNext E{p.x, p.out, mod + 4096, H, p.l1_norm, mod + 3 * 6144 + 2048, RSS};
        pg8::gemm_phase<EpiResNext, pg8::StaticOrder, false>(lds, g, S, E, nullptr);
    }
    GRID_BAR();

    {
        pg8::Gemm g{H, WtIn1, MTOK, 4096, 2048, 2048, 2048}; pg8::StaticOrder S; S.init(MTOK, 4096, G, bid);
        EpiBNorm E{QKV, 4096, RSS, BIAS1};
        pg8::gemm_phase<EpiBNorm, pg8::StaticOrder, false>(lds, g, S, E, nullptr);
#if REP_G2 > 1
        pg8::gemm_phase<EpiBNorm, pg8::StaticOrder, false>(lds, g, S, E, nullptr);
#endif
    }
    GRID_BAR();

#if REP_MEM > 1
    pool_phase(QKV, p.l1_scale, AB);
#endif
    pool_phase(QKV, p.l1_scale, AB);
    GRID_BAR();

    {
        pg8::Gemm g{AB, WtOut1, MTOK, 2048, 2048, 2048, 2048}; pg8::StaticOrder S; S.init(MTOK, 2048, G, bid);
        EpiGateB E{H, mod + 3 * 6144 + 4096};
        pg8::gemm_phase<EpiGateB, pg8::StaticOrder, false>(lds, g, S, E, nullptr);
    }
    GRID_BAR();

#ifdef REP_SYNC
    for (int rep = 0; rep < REP_SYNC; ++rep) GRID_BAR();
#endif
    final_norm_phase(p.out, H, p.final_norm);
}

extern "C" void kernel_launch(void* const* d_in, const int* in_sizes, int n_in, void* d_out, int out_size, void* d_ws, size_t ws_size, hipStream_t stream) {
    static int grid_blocks = 0;
    if (!grid_blocks) {
        int dev = 0, cus = 0, per_cu = 0;
        (void)hipGetDevice(&dev);
        (void)hipDeviceGetAttribute(&cus, hipDeviceAttributeMultiprocessorCount, dev);
        (void)hipFuncSetAttribute((const void*)fwd_mega, hipFuncAttributeMaxDynamicSharedMemorySize, LDS_BYTES);
        (void)hipOccupancyMaxActiveBlocksPerMultiprocessor(&per_cu, (const void*)fwd_mega, 512, LDS_BYTES);
        if (per_cu < 1) per_cu = 1;
        grid_blocks = cus * per_cu;
        if (ws_size < WS_END) fprintf(stderr, "kernel_launch: workspace too small (%zu < %zu)\n", ws_size, (size_t)WS_END);
    }
    Params p{};
    p.x = (const float*)d_in[0]; p.c = (const float*)d_in[1]; p.ctx = (const float*)d_in[2]; p.c_ctx = (const float*)d_in[3];
    p.l0_norm = (const float*)d_in[4]; p.l0_w_mod = (const float*)d_in[5]; p.l0_b_mod = (const float*)d_in[6]; p.l0_w_in = (const float*)d_in[7];
    p.l0_sink = (const float*)d_in[8]; p.l0_w_f = (const float*)d_in[9]; p.l0_w_out = (const float*)d_in[10];
    p.l1_norm = (const float*)d_in[11]; p.l1_w_mod = (const float*)d_in[12]; p.l1_b_mod = (const float*)d_in[13]; p.l1_w_in = (const float*)d_in[14];
    p.l1_w_grp = (const float*)d_in[15]; p.l1_scale = (const float*)d_in[16]; p.l1_w_out = (const float*)d_in[17]; p.final_norm = (const float*)d_in[18];
    p.out = (float*)d_out; p.ws = (unsigned char*)d_ws;
#ifndef USE_CG_SYNC
    (void)hipMemsetAsync((char*)d_ws + WS_XBAR, 0, 16384, stream);
#endif
    void* args[] = {&p};
    hipError_t e = hipLaunchCooperativeKernel((void*)fwd_mega, dim3(grid_blocks), dim3(512), args, LDS_BYTES, stream);
    if (e != hipSuccess) fprintf(stderr, "cooperative launch failed: %s (grid %d)\n", hipGetErrorString(e), grid_blocks);
}
```
